# Optimizing an MI355X kernel written in HIP

```python
import jax, jax.numpy as jnp
from jax import lax
import numpy as np

D_MODEL = 1024
BATCH = 4
SEQ = 4096
DEPTH = 1
DEC_BATCH = 128
DEC_SEQ = 8
PAST_LEN = 16384
PAGE_SIZE = 128

HEAD_DIM = 64
SWA_KV_HEADS = 2
SWA_GROUP = 3
SWA_WINDOW = 128
DIL_HEADS = 6
DIL_PATTERNS = ((128, 1), (512, 4), (2048, 16))
DIL_MAX_WINDOW = 2048
MEM_HEADS = 4
MEM_TOKENS = 256
BLK = 128
ROPE_THETA = 10000.0
EPS = 1e-6
SCALE = HEAD_DIM ** -0.5
Q_A = SWA_KV_HEADS * SWA_GROUP * HEAD_DIM
KV_A = SWA_KV_HEADS * HEAD_DIM
Q_B = DIL_HEADS * HEAD_DIM
KV_B = DIL_HEADS * HEAD_DIM
Q_X = MEM_HEADS * HEAD_DIM
IN_SIZES = (Q_A, KV_A, KV_A, Q_B, KV_B, KV_B, Q_X)
IN_WIDTH = Q_A + 2 * KV_A + Q_B + 2 * KV_B + Q_X
MIX_WIDTH = Q_A + Q_B + Q_X
D_FF = ((8 * D_MODEL + 3 * 256 - 1) // (3 * 256)) * 256

kernel_name = "hymba_swa_sink_dilated_memxattn_decoder_step"


def rms_norm(x, g):
    xf = x.astype(jnp.float32)
    y = xf * lax.rsqrt(jnp.mean(xf * xf, axis=-1, keepdims=True) + EPS)
    return (y * g.astype(jnp.float32)).astype(x.dtype)


def rotary(x, pos):
    half = HEAD_DIM // 2
    inv = ROPE_THETA ** (-jnp.arange(half, dtype=jnp.float32) / half)
    ang = pos.astype(jnp.float32)[:, None] * inv[None, :]
    shape = (1, pos.shape[0]) + (1,) * (x.ndim - 3) + (half,)
    cos = jnp.cos(ang).reshape(shape)
    sin = jnp.sin(ang).reshape(shape)
    xf = x.astype(jnp.float32)
    x1, x2 = xf[..., :half], xf[..., half:]
    return jnp.concatenate([x1 * cos - x2 * sin, x2 * cos + x1 * sin], axis=-1).astype(x.dtype)


def banded_stats(q, k, v, window):
    b, t, hk, g, dh = q.shape
    nb = -(-t // BLK)
    pad = nb * BLK - t
    qb = jnp.pad(q, ((0, 0), (0, pad), (0, 0), (0, 0), (0, 0))).reshape(b, nb, BLK, hk, g, dh)
    kp = jnp.pad(k, ((0, 0), (BLK, pad), (0, 0), (0, 0))).reshape(b, nb + 1, BLK, hk, dh)
    vp = jnp.pad(v, ((0, 0), (BLK, pad), (0, 0), (0, 0))).reshape(b, nb + 1, BLK, hk, dh)
    kw = jnp.concatenate([kp[:, :-1], kp[:, 1:]], axis=2)
    vw = jnp.concatenate([vp[:, :-1], vp[:, 1:]], axis=2)
    s = jnp.einsum('bnqhgd,bnkhd->bnhgqk', qb, kw, preferred_element_type=jnp.float32) * SCALE
    qi = jnp.arange(BLK)[:, None]
    kj = jnp.arange(2 * BLK)[None, :]
    dist = qi + BLK - kj
    kabs = jnp.arange(nb)[:, None, None] * BLK + kj[None] - BLK
    mask = (dist >= 0)[None] & (dist <= window)[None] & (kabs >= 0)
    s = jnp.where(mask[None, :, None, None], s, -jnp.inf)
    m = jnp.max(s, axis=-1, keepdims=True)
    p = jnp.exp(s - m)
    l = jnp.sum(p, axis=-1)
    o = jnp.einsum('bnhgqk,bnkhd->bnqhgd', p, vw.astype(jnp.float32))
    o = o.reshape(b, nb * BLK, hk, g, dh)[:, :t]
    m = jnp.moveaxis(m[..., 0], -1, 2).reshape(b, nb * BLK, hk, g)[:, :t]
    l = jnp.moveaxis(l, -1, 2).reshape(b, nb * BLK, hk, g)[:, :t]
    return o, m, l


def window_gather_stats(q, k_all, v_all, start, window, stride):
    s_len = q.shape[1]
    n_k = window // stride + 1
    idx = start + jnp.arange(s_len)[:, None] - stride * jnp.arange(n_k)[None, :]
    valid = idx >= 0
    idx = jnp.maximum(idx, 0)
    kg = k_all[:, idx]
    vg = v_all[:, idx]
    sc = jnp.einsum('nshgd,nskhd->nshgk', q, kg, preferred_element_type=jnp.float32) * SCALE
    sc = jnp.where(valid[None, :, None, None, :], sc, -jnp.inf)
    m = jnp.max(sc, axis=-1, keepdims=True)
    p = jnp.exp(sc - m)
    l = jnp.sum(p, axis=-1)
    o = jnp.einsum('nshgk,nskhd->nshgd', p, vg.astype(jnp.float32))
    return o, m[..., 0], l


def sink_combine(o, m, l, sink):
    sink = sink.astype(jnp.float32)
    mm = jnp.maximum(m, sink)
    a = jnp.exp(m - mm)
    den = l * a + jnp.exp(sink - mm)
    return o * (a / den)[..., None]


def dilation_combine(stats):
    m_top = jnp.max(jnp.stack([m for _, m, _ in stats]), axis=0)
    num = sum(o * jnp.exp(m - m_top)[..., None] for o, m, _ in stats)
    den = sum(l * jnp.exp(m - m_top) for _, m, l in stats)
    return num / den[..., None]


def fold_stride(x, r):
    b, t = x.shape[:2]
    x = jnp.moveaxis(x.reshape((b, t // r, r) + x.shape[2:]), 2, 1)
    return x.reshape((b * r, t // r) + x.shape[3:])


def unfold_stride(x, b, r):
    br, tr = x.shape[:2]
    x = jnp.moveaxis(x.reshape((b, r, tr) + x.shape[2:]), 1, 2)
    return x.reshape((b, tr * r) + x.shape[3:])


def dilated_prompt(q, k, v):
    b = q.shape[0]
    stats = []
    for w, r in DIL_PATTERNS:
        o, m, l = banded_stats(fold_stride(q, r), fold_stride(k, r), fold_stride(v, r), w // r)
        stats.append((unfold_stride(o, b, r), unfold_stride(m, b, r), unfold_stride(l, b, r)))
    return dilation_combine(stats)


def dilated_sample(q, k_all, v_all, start):
    stats = [window_gather_stats(q, k_all, v_all, start, w, r) for w, r in DIL_PATTERNS]
    return dilation_combine(stats)


def mix_inputs(u, w_in, pos):
    b, t = u.shape[:2]
    z = jnp.einsum('btd,de->bte', u, w_in)
    qa, ka, va, qb, kb, vb, qx = jnp.split(z, np.cumsum(IN_SIZES)[:-1], axis=-1)
    qa = rotary(qa.reshape(b, t, SWA_KV_HEADS, SWA_GROUP, HEAD_DIM), pos)
    ka = rotary(ka.reshape(b, t, SWA_KV_HEADS, HEAD_DIM), pos)
    va = va.reshape(b, t, SWA_KV_HEADS, HEAD_DIM)
    qb = rotary(qb.reshape(b, t, DIL_HEADS, 1, HEAD_DIM), pos)
    kb = rotary(kb.reshape(b, t, DIL_HEADS, HEAD_DIM), pos)
    vb = vb.reshape(b, t, DIL_HEADS, HEAD_DIM)
    qx = qx.reshape(b, t, MEM_HEADS, HEAD_DIM)
    return qa, ka, va, qb, kb, vb, qx


def mem_kv(mem, w_mem_kv):
    b, n = mem.shape[:2]
    mk, mv = jnp.split(jnp.einsum('bmd,de->bme', mem, w_mem_kv), 2, axis=-1)
    return mk.reshape(b, n, MEM_HEADS, HEAD_DIM), mv.reshape(b, n, MEM_HEADS, HEAD_DIM)


def mem_attend(qx, mk, mv):
    s = jnp.einsum('bthd,bmhd->bhtm', qx, mk, preferred_element_type=jnp.float32) * SCALE
    p = jax.nn.softmax(s, axis=-1)
    return jnp.einsum('bhtm,bmhd->bthd', p, mv.astype(jnp.float32))


def swiglu(h, w_gate, w_up, w_down):
    g = jnp.einsum('btd,df->btf', h, w_gate)
    u = jnp.einsum('btd,df->btf', h, w_up)
    return jnp.einsum('btf,fd->btd', jax.nn.silu(g) * u, w_down)


def finish_layer(x, oa, ob, ox, w_o, g_post_mix, g_pre_ffn, w_gate, w_up, w_down, g_post_ffn):
    b, t = x.shape[:2]
    cat = jnp.concatenate([oa.reshape(b, t, -1), ob.reshape(b, t, -1), ox.reshape(b, t, -1)],
                          axis=-1).astype(x.dtype)
    x = x + rms_norm(jnp.einsum('bte,ed->btd', cat, w_o), g_post_mix)
    x = x + rms_norm(swiglu(rms_norm(x, g_pre_ffn), w_gate, w_up, w_down), g_post_ffn)
    return x


def setup_inputs(seed: int = 0) -> dict:
    key = jax.random.key(seed)
    ks = jax.random.split(key, 24)
    f32 = jnp.float32
    lb_a = min(SWA_WINDOW, PAST_LEN)
    lb_b = min(DIL_MAX_WINDOW, PAST_LEN)

    def nrm(k, shape, scale=1.0):
        return scale * jax.random.normal(k, shape, f32)

    def gain(k):
        return 1.0 + 0.02 * jax.random.normal(k, (DEPTH, D_MODEL), f32)

    return {
        "x_prompt": nrm(ks[0], (BATCH, SEQ, D_MODEL)),
        "x_sample": nrm(ks[1], (DEC_BATCH, DEC_SEQ, D_MODEL)),
        "cache_swa_k": nrm(ks[2], (DEPTH, DEC_BATCH, lb_a, SWA_KV_HEADS, HEAD_DIM)),
        "cache_swa_v": nrm(ks[3], (DEPTH, DEC_BATCH, lb_a, SWA_KV_HEADS, HEAD_DIM)),
        "cache_dil_k": nrm(ks[4], (DEPTH, DEC_BATCH, lb_b, DIL_HEADS, HEAD_DIM)),
        "cache_dil_v": nrm(ks[5], (DEPTH, DEC_BATCH, lb_b, DIL_HEADS, HEAD_DIM)),
        "cache_mem_k": nrm(ks[6], (DEPTH, DEC_BATCH, MEM_TOKENS, MEM_HEADS, HEAD_DIM)),
        "cache_mem_v": nrm(ks[7], (DEPTH, DEC_BATCH, MEM_TOKENS, MEM_HEADS, HEAD_DIM)),
        "mem_prompt": nrm(ks[8], (BATCH, MEM_TOKENS, D_MODEL)),
        "g_pre_mix": gain(ks[9]),
        "w_in": nrm(ks[10], (DEPTH, D_MODEL, IN_WIDTH), D_MODEL ** -0.5),
        "sinks": nrm(ks[11], (DEPTH, SWA_KV_HEADS, SWA_GROUP)),
        "w_mem_kv": nrm(ks[12], (DEPTH, D_MODEL, 2 * MEM_HEADS * HEAD_DIM), D_MODEL ** -0.5),
        "w_o": nrm(ks[13], (DEPTH, MIX_WIDTH, D_MODEL), MIX_WIDTH ** -0.5),
        "g_post_mix": gain(ks[14]),
        "g_pre_ffn": gain(ks[15]),
        "w_gate": nrm(ks[16], (DEPTH, D_MODEL, D_FF), D_MODEL ** -0.5),
        "w_up": nrm(ks[17], (DEPTH, D_MODEL, D_FF), D_MODEL ** -0.5),
        "w_down": nrm(ks[18], (DEPTH, D_FF, D_MODEL), D_FF ** -0.5),
        "g_post_ffn": gain(ks[19]),
    }


def reference(x_prompt, x_sample, cache_swa_k, cache_swa_v, cache_dil_k, cache_dil_v,
              cache_mem_k, cache_mem_v, mem_prompt, g_pre_mix, w_in, sinks, w_mem_kv, w_o,
              g_post_mix, g_pre_ffn, w_gate, w_up, w_down, g_post_ffn):
    t_p = x_prompt.shape[1]
    s_len = x_sample.shape[1]
    lb_a = cache_swa_k.shape[2]
    lb_b = cache_dil_k.shape[2]
    pos_p = jnp.arange(t_p)
    pos_s = PAST_LEN + jnp.arange(s_len)
    hp, hs = x_prompt, x_sample
    p_swa_k, p_swa_v, p_dil_k, p_dil_v, p_mem_k, p_mem_v = [], [], [], [], [], []
    s_swa_k, s_swa_v, s_dil_k, s_dil_v = [], [], [], []
    for l in range(DEPTH):
        u = rms_norm(hp, g_pre_mix[l])
        qa, ka, va, qb, kb, vb, qx = mix_inputs(u, w_in[l], pos_p)
        mk, mv = mem_kv(mem_prompt, w_mem_kv[l])
        oa = sink_combine(*banded_stats(qa, ka, va, SWA_WINDOW), sinks[l])
        ob = dilated_prompt(qb, kb, vb)
        ox = mem_attend(qx, mk, mv)
        hp = finish_layer(hp, oa, ob, ox, w_o[l], g_post_mix[l], g_pre_ffn[l],
                          w_gate[l], w_up[l], w_down[l], g_post_ffn[l])
        p_swa_k.append(ka[:, t_p - min(SWA_WINDOW, t_p):])
        p_swa_v.append(va[:, t_p - min(SWA_WINDOW, t_p):])
        p_dil_k.append(kb[:, t_p - min(DIL_MAX_WINDOW, t_p):])
        p_dil_v.append(vb[:, t_p - min(DIL_MAX_WINDOW, t_p):])
        p_mem_k.append(mk)
        p_mem_v.append(mv)

        u = rms_norm(hs, g_pre_mix[l])
        qa, ka, va, qb, kb, vb, qx = mix_inputs(u, w_in[l], pos_s)
        ka_all = jnp.concatenate([cache_swa_k[l], ka.astype(cache_swa_k.dtype)], axis=1)
        va_all = jnp.concatenate([cache_swa_v[l], va.astype(cache_swa_v.dtype)], axis=1)
        kb_all = jnp.concatenate([cache_dil_k[l], kb.astype(cache_dil_k.dtype)], axis=1)
        vb_all = jnp.concatenate([cache_dil_v[l], vb.astype(cache_dil_v.dtype)], axis=1)
        oa = sink_combine(*window_gather_stats(qa, ka_all, va_all, lb_a, SWA_WINDOW, 1), sinks[l])
        ob = dilated_sample(qb, kb_all, vb_all, lb_b)
        ox = mem_attend(qx, cache_mem_k[l], cache_mem_v[l])
        hs = finish_layer(hs, oa, ob, ox, w_o[l], g_post_mix[l], g_pre_ffn[l],
                          w_gate[l], w_up[l], w_down[l], g_post_ffn[l])
        s_swa_k.append(ka_all[:, s_len:])
        s_swa_v.append(va_all[:, s_len:])
        s_dil_k.append(kb_all[:, s_len:])
        s_dil_v.append(vb_all[:, s_len:])
    return (hp, hs,
            jnp.stack(p_swa_k), jnp.stack(p_swa_v), jnp.stack(p_dil_k), jnp.stack(p_dil_v),
            jnp.stack(p_mem_k), jnp.stack(p_mem_v),
            jnp.stack(s_swa_k), jnp.stack(s_swa_v), jnp.stack(s_dil_k), jnp.stack(s_dil_v))
```

```cpp
#include <hip/hip_runtime.h>
#include <hip/hip_cooperative_groups.h>
#include <cstdio>
#include <cstdint>
namespace cg = cooperative_groups;
namespace pg8 {
#define PG8_LAS __attribute__((address_space(3)))
typedef unsigned short bf16_t;
typedef short bf16x8 __attribute__((ext_vector_type(8)));
typedef float f32x4 __attribute__((ext_vector_type(4)));
typedef unsigned u32x4 __attribute__((ext_vector_type(4)));
constexpr int BM = 256, BK = 64, HALF = 128, HTB = HALF * BK * 2  , STAGE_BYTES = 8 * HTB, NXCD = 8, WGM = 8;

__host__ __device__ __forceinline__ int lds_byte(int r, int c) { const int st = (r >> 4) * 2 + (c >> 5), rr = r & 15, cc = c & 31, ob = rr * 64 + cc * 2; return st * 1024 + (ob ^ (((ob >> 9) & 1) << 5)); }
__host__ __device__ __forceinline__ void stage_rc(int b, int& R, int& C) { const int st = b / 1024, sb = b % 1024, swz = sb ^ (((sb >> 9) & 1) << 5); R = (st >> 1) * 16 + swz / 64; C = (st & 1) * 32 + (swz % 64) / 2; }
__host__ __device__ __forceinline__ int perm32(int rho) { const int n = rho >> 4, i = rho & 15; return 8 * (i >> 2) + 4 * n + (i & 3); }

struct Unit { int pm, pn, ks, kt; };
struct Gemm { const bf16_t* A; const bf16_t* Bt; int M, N, K; };

struct StaticOrder {
    int nM, nN, nwg, G, c;
    __host__ __device__ void init(int M, int N, int G_, int c_) { nM = M / BM; nN = N / BM; nwg = nM * nN; G = G_; c = c_; }
    __host__ __device__ bool next(int i, Unit& u) const {
        const long L = (long)i * G + c; if (L >= nwg) return false;
        int wgid = (int)L; { const int q = nwg / NXCD, r = nwg % NXCD, xcd = wgid % NXCD, off = wgid / NXCD; wgid = (xcd < r ? xcd * (q + 1) : r * (q + 1) + (xcd - r) * q) + off; }
        const int nig = WGM * nN, gid = wgid / nig, fm = gid * WGM, gsz = (nM - fm) < WGM ? (nM - fm) : WGM;
        u.pm = fm + ((wgid % nig) % gsz); u.pn = (wgid % nig) / gsz; u.ks = 0; u.kt = 0; return true;
    }
    __device__ __forceinline__ void a_ready(const Unit&) const {}
    __device__ __forceinline__ void done(const Unit&) const {}
};

__device__ __forceinline__ unsigned cvt_pk_bf16(float lo, float hi) { unsigned r; asm volatile("v_cvt_pk_bf16_f32 %0, %1, %2" : "=v"(r) : "v"(lo), "v"(hi)); return r; }
template <class Epi, class Sched, bool ALIGN_EPI = false, bool SP2 = false>
__device__ __forceinline__ void gemm_phase(PG8_LAS unsigned char* lds, const Gemm g, const Sched& S, const Epi& E) {
    int tid_ = threadIdx.x; asm volatile("" : "+v"(tid_));
    const int tid = tid_, wid = __builtin_amdgcn_readfirstlane(tid >> 6), lane = tid & 63, wr = wid >> 2, wc = wid & 3, fr = lane & 15, fq = lane >> 4;
    const int K = g.K;
    unsigned voffA[2], voffB[2];
#pragma unroll
    for (int i = 0; i < 2; ++i) { int R, C; stage_rc(tid * 16 + i * 8192, R, C); const int Rb = Epi::PERM ? ((R & ~31) + perm32(R & 31)) : R;
        voffA[i] = (unsigned)(R * K + C) * 2u; voffB[i] = (unsigned)(Rb * K + C) * 2u; }
    const size_t kstep = (size_t)(BK * 2);
    const size_t hstep = (size_t)HALF * K * 2;
    const size_t tstep = 2 * hstep;
    const unsigned ldsw = (unsigned)wid * 1024u;
    const int aoff = lds_byte(wr * 64 + fr, fq * 8), boff = lds_byte(wc * 32 + fr, fq * 8);
#define PG8_SA(b, h) (((b) * 2 + (h)) * HTB)
#define PG8_SB(b, h) ((4 + (b) * 2 + (h)) * HTB)
#define PG8_STAGE(bufoff, gbase, voff) do { _Pragma("unroll") for (int _i = 0; _i < 2; ++_i) \
        __builtin_amdgcn_global_load_lds((const unsigned*)((const char*)(gbase) + (voff)[_i]), (PG8_LAS unsigned*)(lds + (bufoff) + ldsw + _i * 8192), 16, 0, 0); } while (0)
#define PG8_LDA(dst, b, h) do { _Pragma("unroll") for (int m = 0; m < 4; ++m) _Pragma("unroll") for (int k = 0; k < 2; ++k) dst[m][k] = *(const PG8_LAS bf16x8*)(lds + PG8_SA(b, h) + aoff + m * 2048 + k * 1024); } while (0)
#define PG8_LDB(dst, b, h) do { _Pragma("unroll") for (int n = 0; n < 2; ++n) _Pragma("unroll") for (int k = 0; k < 2; ++k) dst[n][k] = *(const PG8_LAS bf16x8*)(lds + PG8_SB(b, h) + boff + n * 2048 + k * 1024); } while (0)
#define PG8_MMA(ai, bj, At, Bt) do { __builtin_amdgcn_s_setprio(1); _Pragma("unroll") for (int m = 0; m < 4; ++m) _Pragma("unroll") for (int n = 0; n < 2; ++n) _Pragma("unroll") for (int k = 0; k < 2; ++k) \
        acc[ai][bj][m][n] = __builtin_amdgcn_mfma_f32_16x16x32_bf16(Bt[n][k], At[m][k], acc[ai][bj][m][n], 0, 0, 0); __builtin_amdgcn_s_setprio(0); } while (0)
#define PG8_WAIT_V(n) asm volatile("s_waitcnt vmcnt(" #n ")" ::: "memory")
#define PG8_WAIT_L(n) asm volatile("s_waitcnt lgkmcnt(" #n ")" ::: "memory")
#define PG8_BAR __builtin_amdgcn_s_barrier()
#define PG8_SCHED __builtin_amdgcn_sched_barrier(0)
    Unit cur, nxt; int ui = 0;
    if (!S.next(0, cur)) return;
    f32x4 acc[2][2][4][2];
#pragma unroll
    for (int a = 0; a < 2; ++a)
#pragma unroll
        for (int b = 0; b < 2; ++b)
#pragma unroll
            for (int m = 0; m < 4; ++m)
#pragma unroll
                for (int n = 0; n < 2; ++n) acc[a][b][m][n] = (f32x4){0.f, 0.f, 0.f, 0.f};
    bf16x8 At[4][2], B0[2][2], B1[2][2];
    const char* cA = (const char*)g.A + (size_t)cur.pm * tstep + (size_t)cur.ks * 2; const char* cB = (const char*)g.Bt + (size_t)cur.pn * tstep + (size_t)cur.ks * 2;
    S.a_ready(cur);
    if constexpr (SP2) {
        PG8_STAGE(PG8_SB(0, 0), cB, voffB); PG8_STAGE(PG8_SB(0, 1), cB + hstep, voffB); PG8_STAGE(PG8_SA(0, 0), cA, voffA); PG8_STAGE(PG8_SA(0, 1), cA + hstep, voffA);
        if (wr == 1) PG8_BAR;
        PG8_WAIT_V(2); PG8_BAR;
        PG8_STAGE(PG8_SB(1, 0), cB + kstep, voffB); PG8_STAGE(PG8_SA(1, 0), cA + kstep, voffA); PG8_STAGE(PG8_SB(1, 1), cB + hstep + kstep, voffB);
        PG8_WAIT_V(6); PG8_BAR;
    } else {
        PG8_STAGE(PG8_SB(0, 0), cB, voffB); PG8_STAGE(PG8_SA(0, 0), cA, voffA); PG8_STAGE(PG8_SB(0, 1), cB + hstep, voffB); PG8_STAGE(PG8_SA(0, 1), cA + hstep, voffA);
        if (wr == 1) PG8_BAR;
        PG8_WAIT_V(4); PG8_BAR;
        PG8_STAGE(PG8_SB(1, 0), cB + kstep, voffB); PG8_STAGE(PG8_SA(1, 0), cA + kstep, voffA); PG8_STAGE(PG8_SB(1, 1), cB + hstep + kstep, voffB);
        PG8_WAIT_V(6); PG8_BAR;
    }
    for (;;) {
        const bool has_next = S.next(ui + 1, nxt);
        const char* nA = has_next ? (const char*)g.A + (size_t)nxt.pm * tstep + (size_t)nxt.ks * 2 : cA; const char* nB = has_next ? (const char*)g.Bt + (size_t)nxt.pn * tstep + (size_t)nxt.ks * 2 : cB;
        const int nt = (cur.kt ? cur.kt : K) / BK;
        for (int t = 0; t < nt; t += 2) {
            const bool last = (t == nt - 2);
            const char* a1 = cA + (size_t)(t + 1) * kstep;
            const char* a2 = last ? nA : cA + (size_t)(t + 2) * kstep; const char* b2 = last ? nB : cB + (size_t)(t + 2) * kstep;
            const char* a3 = a2 + kstep; const char* b3 = b2 + kstep;
            if (last && has_next) S.a_ready(nxt);
            if constexpr (SP2) {
            PG8_LDB(B0, 0, 0); PG8_LDB(B1, 0, 1); PG8_SCHED; PG8_LDA(At, 0, 0); PG8_STAGE(PG8_SA(1, 1), a1 + hstep, voffA);
            PG8_WAIT_V(8); PG8_WAIT_L(0); PG8_BAR; PG8_MMA(0, 0, At, B0); PG8_MMA(0, 1, At, B1); PG8_BAR; PG8_SCHED;
            PG8_LDA(At, 0, 1); PG8_STAGE(PG8_SB(0, 0), b2, voffB); PG8_STAGE(PG8_SB(0, 1), b2 + hstep, voffB); PG8_STAGE(PG8_SA(0, 0), a2, voffA);
            PG8_WAIT_V(8); PG8_WAIT_L(0); PG8_BAR; PG8_MMA(1, 0, At, B0); PG8_MMA(1, 1, At, B1); PG8_BAR; PG8_SCHED;
            PG8_LDB(B0, 1, 0); PG8_LDB(B1, 1, 1); PG8_SCHED; PG8_LDA(At, 1, 0); PG8_STAGE(PG8_SA(0, 1), a2 + hstep, voffA);
            PG8_WAIT_V(8); PG8_WAIT_L(0); PG8_BAR; PG8_MMA(0, 0, At, B0); PG8_MMA(0, 1, At, B1); PG8_BAR; PG8_SCHED;
            PG8_LDA(At, 1, 1); PG8_STAGE(PG8_SB(1, 0), b3, voffB); PG8_STAGE(PG8_SB(1, 1), b3 + hstep, voffB); PG8_STAGE(PG8_SA(1, 0), a3, voffA);
            PG8_WAIT_V(8); PG8_WAIT_L(0); PG8_BAR; PG8_MMA(1, 0, At, B0); PG8_MMA(1, 1, At, B1); PG8_BAR; PG8_SCHED;
            } else {
            PG8_LDB(B0, 0, 0); PG8_SCHED; PG8_LDA(At, 0, 0); PG8_STAGE(PG8_SA(1, 1), a1 + hstep, voffA);
            PG8_WAIT_L(8); PG8_BAR; PG8_WAIT_L(0); PG8_MMA(0, 0, At, B0); PG8_BAR; PG8_SCHED;
            PG8_LDB(B1, 0, 1); PG8_STAGE(PG8_SB(0, 0), b2, voffB);
            PG8_BAR; PG8_WAIT_L(0); PG8_MMA(0, 1, At, B1); PG8_BAR;
            PG8_LDA(At, 0, 1); PG8_STAGE(PG8_SA(0, 0), a2, voffA);
            PG8_BAR; PG8_WAIT_L(0); PG8_MMA(1, 0, At, B0); PG8_BAR; PG8_SCHED;
            PG8_STAGE(PG8_SB(0, 1), b2 + hstep, voffB);
            PG8_WAIT_V(6); PG8_BAR; PG8_MMA(1, 1, At, B1); PG8_BAR;
            PG8_LDB(B0, 1, 0); PG8_SCHED; PG8_LDA(At, 1, 0); PG8_STAGE(PG8_SA(0, 1), a2 + hstep, voffA);
            PG8_WAIT_L(8); PG8_BAR; PG8_WAIT_L(0); PG8_MMA(0, 0, At, B0); PG8_BAR; PG8_SCHED;
            PG8_LDB(B1, 1, 1); PG8_STAGE(PG8_SB(1, 0), b3, voffB);
            PG8_BAR; PG8_WAIT_L(0); PG8_MMA(0, 1, At, B1); PG8_BAR;
            PG8_LDA(At, 1, 1); PG8_STAGE(PG8_SA(1, 0), a3, voffA);
            PG8_BAR; PG8_WAIT_L(0); PG8_MMA(1, 0, At, B0); PG8_BAR; PG8_SCHED;
            PG8_STAGE(PG8_SB(1, 1), b3 + hstep, voffB);
            PG8_WAIT_V(6); PG8_BAR; PG8_MMA(1, 1, At, B1); PG8_BAR;
            }
        }
        if constexpr (ALIGN_EPI) { if (wr == 0) PG8_BAR; }
        if constexpr (!Epi::AFTER_DRAIN) { E(acc, cur, wr, wc, fr, fq); S.done(cur); }
        if (!has_next) break;
#pragma unroll
        for (int a = 0; a < 2; ++a)
#pragma unroll
            for (int b = 0; b < 2; ++b)
#pragma unroll
                for (int m = 0; m < 4; ++m)
#pragma unroll
                    for (int n = 0; n < 2; ++n) acc[a][b][m][n] = (f32x4){0.f, 0.f, 0.f, 0.f};
        cur = nxt; cA = nA; cB = nB; ++ui;
        if constexpr (ALIGN_EPI) { if (wr == 1) PG8_BAR; }
    }
    PG8_WAIT_V(0);
    if constexpr (!ALIGN_EPI) { if (wr == 0) PG8_BAR; }
    PG8_BAR;
    if constexpr (Epi::AFTER_DRAIN) { E.fused(acc, cur, wr, wc, fr, fq, lds, wid, lane); S.done(cur); }
#undef PG8_SA
#undef PG8_SB
#undef PG8_STAGE
#undef PG8_LDA
#undef PG8_LDB
#undef PG8_MMA
#undef PG8_WAIT_V
#undef PG8_WAIT_L
#undef PG8_BAR
#undef PG8_SCHED
}
}

using namespace pg8;
#define LAS __attribute__((address_space(3)))
#define DI __device__ __forceinline__
typedef short s16x4 __attribute__((ext_vector_type(4)));
typedef short v4i16_t __attribute__((ext_vector_type(4)));
typedef float f32x16 __attribute__((ext_vector_type(16)));
typedef float f32x2_t __attribute__((ext_vector_type(2)));
typedef __bf16 bf16x2_t __attribute__((ext_vector_type(2)));
typedef unsigned u32x2 __attribute__((ext_vector_type(2)));

constexpr int NP = 16384, NS = 1024, NT = 17408, DM = 1024, DFF = 2816;
constexpr float EPS = 1e-6f;
constexpr float LOG2E = 1.4426950408889634f;
constexpr float QSCALE = 0.125f * LOG2E;
constexpr float NEGBIG = -1e30f;

constexpr size_t O_Y = 0;
constexpr size_t O_PSK = 17825792;
constexpr size_t O_PSV = 17891328;
constexpr size_t O_PDK = 17956864;
constexpr size_t O_PDV = 21102592;
constexpr size_t O_PMK = 24248320;
constexpr size_t O_PMV = 24510464;
constexpr size_t O_SSK = 24772608;
constexpr size_t O_SSV = 26869760;
constexpr size_t O_SDK = 28966912;
constexpr size_t O_SDV = 129630208;

constexpr size_t MiB = 1u << 20;
constexpr size_t WS_ROT = 1 * MiB;
constexpr size_t WS_WIN = 4 * MiB;
constexpr size_t WS_WO = 10 * MiB;
constexpr size_t WS_WGU = 12 * MiB;
constexpr size_t WS_WD = 24 * MiB;
constexpr size_t WS_AALL = 32 * MiB;
constexpr size_t WS_ZQ = 68 * MiB;
constexpr size_t WS_KA = 102 * MiB;
constexpr size_t WS_VA = 106 * MiB;
constexpr size_t WS_KB = 110 * MiB;
constexpr size_t WS_VB = 122 * MiB;
constexpr size_t WS_MK = 134 * MiB;
constexpr size_t WS_MV = 135 * MiB;
constexpr size_t WS_CAT = 136 * MiB;
constexpr size_t WS_BPO = 170 * MiB;
constexpr size_t WS_BPM = 210 * MiB;
constexpr size_t WS_T = 214 * MiB;
constexpr size_t WS_SS = 250 * MiB;
constexpr size_t WS_ACT = 252 * MiB;
constexpr size_t WS_PART = 348 * MiB;
constexpr size_t WS_END = 392 * MiB;

constexpr int LDS_BYTES = 131072 + 256;
constexpr size_t WS_CTL = 0, CTL_ZERO_BYTES = 65536;

__device__ const double INVF[32] = {
    1.0, 0.7498942093324559, 0.5623413251903491, 0.4216965034285822, 0.31622776601683794, 0.23713737056616552, 0.1778279410038923, 0.1333521432163324,
    0.1, 0.07498942093324558, 0.05623413251903491, 0.042169650342858224, 0.03162277660168379, 0.023713737056616554, 0.01778279410038923, 0.01333521432163324,
    0.01, 0.007498942093324558, 0.005623413251903491, 0.004216965034285823, 0.0031622776601683794, 0.0023713737056616554, 0.0017782794100389228, 0.001333521432163324,
    0.001, 0.0007498942093324559, 0.0005623413251903491, 0.00042169650342858224, 0.00031622776601683794, 0.00023713737056616554, 0.00017782794100389227, 0.0001333521432163324};

DI unsigned pk(float lo, float hi) { f32x2_t v = {lo, hi}; bf16x2_t b = __builtin_convertvector(v, bf16x2_t); return __builtin_bit_cast(unsigned, b); }
DI u32x2 pack4(f32x4 v) { u32x2 r; r.x = pk(v[0], v[1]); r.y = pk(v[2], v[3]); return r; }
DI bf16x8 pack8(f32x4 a, f32x4 b) { u32x4 r; r.x = pk(a[0], a[1]); r.y = pk(a[2], a[3]); r.z = pk(b[0], b[1]); r.w = pk(b[2], b[3]); return __builtin_bit_cast(bf16x8, r); }
DI f32x4 unpack4(u32x2 w) { f32x4 r; r[0] = __builtin_bit_cast(float, w.x << 16); r[1] = __builtin_bit_cast(float, w.x & 0xffff0000u); r[2] = __builtin_bit_cast(float, w.y << 16); r[3] = __builtin_bit_cast(float, w.y & 0xffff0000u); return r; }
DI float wave_sum(float v) {
#pragma unroll
    for (int o = 1; o < 64; o <<= 1) v += __shfl_xor(v, o);
    return v;
}
DI float ex2(float x) { return __builtin_amdgcn_exp2f(x); }
DI int fresh_lane() { return (int)__builtin_amdgcn_mbcnt_hi(~0u, __builtin_amdgcn_mbcnt_lo(~0u, 0u)); }

template <int MODE>
DI void tr_item(const float* W0, const float* W1, int K, int NV, int ld, bf16_t* WT, int row_off, LAS float* scr, int item, int lane) {
    const int nblk = NV / 32, kb = item / nblk, nb = item % nblk, k0 = 64 * kb, n0 = 32 * nb;
    const int v = n0 + (lane & 31);
    const float* src = W0; int col = v;
    if (MODE == 1) { const int hb = v >> 6, vv = v & 63; col = hb * 64 + ((vv >> 2) & 1) * 32 + (vv >> 3) * 4 + (vv & 3); }
    if (MODE == 2) { src = ((v >> 2) & 1) ? W1 : W0; col = (v >> 3) * 4 + (v & 3); }
    float tv_[32];
#pragma unroll
    for (int i = 0; i < 32; ++i) tv_[i] = src[(size_t)(k0 + 2 * i + (lane >> 5)) * ld + col];
#pragma unroll
    for (int i = 0; i < 32; ++i) scr[(2 * i + (lane >> 5)) * 33 + (lane & 31)] = tv_[i];
    asm volatile("s_waitcnt lgkmcnt(0)" ::: "memory");
    const int c = lane & 7;
#pragma unroll
    for (int j = 0; j < 4; ++j) { const int n = (lane >> 3) + 8 * j; const LAS float* s = scr + (8 * c) * 33 + n;
        u32x4 o; o.x = pk(s[0 * 33], s[1 * 33]); o.y = pk(s[2 * 33], s[3 * 33]); o.z = pk(s[4 * 33], s[5 * 33]); o.w = pk(s[6 * 33], s[7 * 33]);
        *(u32x4*)(WT + (size_t)(row_off + n0 + n) * K + k0 + 8 * c) = o; }
    asm volatile("s_waitcnt lgkmcnt(0)" ::: "memory");
}

DI void copy_shift(const float* src, float* dst, int nper, int srcoff, size_t stride, int gt, int NGT) {
    const int total = 128 * nper;
    for (int idx = gt; idx < total; idx += NGT) {
        const int n = idx / nper, o = idx - n * nper;
        const f32x4 v = __builtin_nontemporal_load((const f32x4*)(src + (size_t)n * stride + srcoff) + o);
        __builtin_nontemporal_store(v, (f32x4*)(dst + (size_t)n * stride) + o);
    }
}

struct Sched1 {
    StaticOrder so; int G, c;
    __device__ void init(int G_, int c_) { so.init(NT, 2048, G_, c_); G = G_; c = c_; }
    __device__ bool next(int i, Unit& u) const {
        const int L = i * G + c;
        if (L < 544) return so.next(i, u);
        if (L >= 552) return false;
        const int e = L - 544; u.pm = 68 + (e >> 1); u.pn = 8 + (e & 1); u.ks = 0; u.kt = 0; return true;
    }
    DI void a_ready(const Unit&) const {}
    DI void done(const Unit&) const {}
};

struct SchedSK {
    StaticOrder so; int c, nsl;
    __device__ void init(int G_, int c_, int K) { so.init(NP, 1024, G_, c_); c = c_; nsl = K / 256; }
    __device__ bool next(int i, Unit& u) const {
        if (i == 0) return so.next(0, u);
        if (i > 1 || c >= 16 * nsl) return false;
        const int tile = c / nsl, sl = c - tile * nsl;
        u.pm = 64 + (tile >> 2); u.pn = tile & 3; u.ks = sl * 256; u.kt = 256; return true;
    }
    DI void a_ready(const Unit&) const {}
    DI void done(const Unit&) const {}
};

struct EpiQKV {
    static constexpr bool PERM = true, AFTER_DRAIN = false;
    unsigned char* ws; float* out; const f32x4* rot;
    DI void operator()(const f32x4 (&acc)[2][2][4][2], const Unit& u, int wr, int wc, int fr, int fq) const {
        const int g4 = 4 * ((wc & 1) * 4 + fq), hsub = wc >> 1;
        if (u.pn < 8) {
#pragma unroll
            for (int ai = 0; ai < 2; ++ai)
#pragma unroll
                for (int m = 0; m < 4; ++m) {
                    const int row = u.pm * 256 + ai * 128 + wr * 64 + m * 16 + fr;
                    const bool samp = row >= NP;
                    const int ti = samp ? 4096 + (row & 7) : (row & 4095);
                    const f32x4 cs0 = rot[(ti * 32 + g4) >> 1], cs1 = rot[((ti * 32 + g4) >> 1) + 1];
#pragma unroll
                    for (int bj = 0; bj < 2; ++bj) {
                        const int cb = 2 * u.pn + bj;
                        f32x4 x1 = acc[ai][bj][m][0], x2 = acc[ai][bj][m][1];
                        const bool isrot = (cb <= 3) || (cb >= 5 && cb <= 10);
                        if (isrot) {
                            f32x4 o1, o2;
                            o1[0] = x1[0] * cs0[0] - x2[0] * cs0[1]; o2[0] = x2[0] * cs0[0] + x1[0] * cs0[1];
                            o1[1] = x1[1] * cs0[2] - x2[1] * cs0[3]; o2[1] = x2[1] * cs0[2] + x1[1] * cs0[3];
                            o1[2] = x1[2] * cs1[0] - x2[2] * cs1[1]; o2[2] = x2[2] * cs1[0] + x1[2] * cs1[1];
                            o1[3] = x1[3] * cs1[2] - x2[3] * cs1[3]; o2[3] = x2[3] * cs1[2] + x1[3] * cs1[3];
                            x1 = o1; x2 = o2;
                        }
                        if (cb <= 2 || (cb >= 5 && cb <= 7) || cb >= 14) {
                            const int col = cb <= 2 ? (2 * cb + hsub) * 64 : (cb <= 7 ? 384 + (2 * (cb - 5) + hsub) * 64 : 768 + (2 * (cb - 14) + hsub) * 64);
                            x1 = x1 * QSCALE; x2 = x2 * QSCALE;
                            bf16_t* dst = (bf16_t*)(ws + WS_ZQ) + (size_t)row * 1024 + col + g4;
                            *(u32x2*)dst = pack4(x1); *(u32x2*)(dst + 32) = pack4(x2);
                        } else {
                            const bool isA = cb <= 4; const bool isK = (cb == 3) || (cb >= 8 && cb <= 10);
                            const int head = isA ? hsub : (isK ? 2 * (cb - 8) + hsub : 2 * (cb - 11) + hsub);
                            const int nh = isA ? 2 : 6;
                            if (!samp) {
                                bf16_t* base = (bf16_t*)(ws + (isA ? (isK ? WS_KA : WS_VA) : (isK ? WS_KB : WS_VB)));
                                bf16_t* dst = base + (size_t)row * (nh * 64) + head * 64 + g4;
                                *(u32x2*)dst = pack4(x1); *(u32x2*)(dst + 32) = pack4(x2);
                                const int b = row >> 12, t = row & 4095, w0 = isA ? 3968 : 2048;
                                if (t >= w0) {
                                    float* o = out + (isA ? (isK ? O_PSK : O_PSV) : (isK ? O_PDK : O_PDV)) + ((size_t)(b * (4096 - w0) + (t - w0)) * nh + head) * 64 + g4;
                                    *(f32x4*)o = x1; *(f32x4*)(o + 32) = x2;
                                }
                            } else {
                                const int n = (row - NP) >> 3, i = row & 7, Lw = isA ? 128 : 2048;
                                float* o = out + (isA ? (isK ? O_SSK : O_SSV) : (isK ? O_SDK : O_SDV)) + ((size_t)(n * Lw + Lw - 8 + i) * nh + head) * 64 + g4;
                                *(f32x4*)o = x1; *(f32x4*)(o + 32) = x2;
                            }
                        }
                    }
                }
        } else {
#pragma unroll
            for (int ai = 0; ai < 2; ++ai)
#pragma unroll
                for (int m = 0; m < 4; ++m) {
                    const int row = (u.pm - 68) * 256 + ai * 128 + wr * 64 + m * 16 + fr;
#pragma unroll
                    for (int bj = 0; bj < 2; ++bj) {
                        const int cb = 2 * (u.pn - 8) + bj; const bool isK = cb < 2; const int head = 2 * (cb & 1) + hsub;
                        const f32x4 x1 = acc[ai][bj][m][0], x2 = acc[ai][bj][m][1];
                        bf16_t* dst = (bf16_t*)(ws + (isK ? WS_MK : WS_MV)) + (size_t)row * 256 + head * 64 + g4;
                        *(u32x2*)dst = pack4(x1); *(u32x2*)(dst + 32) = pack4(x2);
                        float* o = out + (isK ? O_PMK : O_PMV) + (size_t)row * 256 + head * 64 + g4;
                        *(f32x4*)o = x1; *(f32x4*)(o + 32) = x2;
                    }
                }
        }
    }
};

struct EpiT {
    static constexpr bool PERM = true, AFTER_DRAIN = false;
    bf16_t* T; float* SS; float* PART;
    DI void operator()(const f32x4 (&acc)[2][2][4][2], const Unit& u, int wr, int wc, int fr, int fq) const {
        if (u.kt) {
            float* P = PART + (size_t)(u.ks >> 8) * 1024 * 1024;
#pragma unroll
            for (int ai = 0; ai < 2; ++ai)
#pragma unroll
                for (int m = 0; m < 4; ++m) {
                    const int row = (u.pm - 64) * 256 + ai * 128 + wr * 64 + m * 16 + fr;
#pragma unroll
                    for (int bj = 0; bj < 2; ++bj) {
                        float* d = P + (size_t)row * 1024 + u.pn * 256 + bj * 128 + wc * 32 + fq * 8;
                        *(f32x4*)d = acc[ai][bj][m][0]; *(f32x4*)(d + 4) = acc[ai][bj][m][1];
                    }
                }
            return;
        }
#pragma unroll
        for (int ai = 0; ai < 2; ++ai)
#pragma unroll
            for (int m = 0; m < 4; ++m) {
                const int row = u.pm * 256 + ai * 128 + wr * 64 + m * 16 + fr;
                float s = 0.f;
#pragma unroll
                for (int bj = 0; bj < 2; ++bj) {
                    const f32x4 v0 = acc[ai][bj][m][0], v1 = acc[ai][bj][m][1];
                    s += (v0[0] * v0[0] + v0[1] * v0[1]) + (v0[2] * v0[2] + v0[3] * v0[3]) + (v1[0] * v1[0] + v1[1] * v1[1]) + (v1[2] * v1[2] + v1[3] * v1[3]);
                    u32x4 w; w.x = pk(v0[0], v0[1]); w.y = pk(v0[2], v0[3]); w.z = pk(v1[0], v1[1]); w.w = pk(v1[2], v1[3]);
                    *(u32x4*)(T + (size_t)row * 1024 + u.pn * 256 + bj * 128 + wc * 32 + fq * 8) = w;
                }
                s += __shfl_xor(s, 16); s += __shfl_xor(s, 32);
                if (fq == 0) SS[(size_t)(u.pn * 4 + wc) * NT + row] = s;
            }
    }
};

struct EpiAct {
    static constexpr bool PERM = true, AFTER_DRAIN = false;
    bf16_t* ACT;
    DI void operator()(const f32x4 (&acc)[2][2][4][2], const Unit& u, int wr, int wc, int fr, int fq) const {
#pragma unroll
        for (int ai = 0; ai < 2; ++ai)
#pragma unroll
            for (int m = 0; m < 4; ++m) {
                const int row = u.pm * 256 + ai * 128 + wr * 64 + m * 16 + fr;
#pragma unroll
                for (int bj = 0; bj < 2; ++bj) {
                    const f32x4 g = acc[ai][bj][m][0], up = acc[ai][bj][m][1];
                    f32x4 a;
#pragma unroll
                    for (int e = 0; e < 4; ++e) a[e] = g[e] * __builtin_amdgcn_rcpf(1.f + ex2(-g[e] * LOG2E)) * up[e];
                    *(u32x2*)(ACT + (size_t)row * DFF + u.pn * 128 + bj * 64 + wc * 16 + fq * 4) = pack4(a);
                }
            }
    }
};

#define MFMA32(a, b, c) __builtin_amdgcn_mfma_f32_32x32x16_bf16((a), (b), (c), 0, 0, 0)
DI s16x4 vtr(const LAS unsigned char* p) { return __builtin_bit_cast(s16x4, __builtin_amdgcn_ds_read_tr16_b64_v4i16((LAS v4i16_t*)p)); }

template <bool F32>
DI void load_chunk(f32x4 (&rk)[8], f32x4 (&rv)[8], u32x4 (&bk)[4], u32x4 (&bv)[4], int f0,
                   const void* kb0, const void* kb1, const void* vb0, const void* vb1, int pitch, int L, int c, int rr, int fmax, int lane) {
    if (!F32) {
        const int row0 = c + rr * (f0 + (lane >> 3));
        const bf16_t* kp = (const bf16_t*)kb0 + (size_t)row0 * pitch + 8 * (lane & 7);
        const bf16_t* vp = (const bf16_t*)vb0 + (size_t)row0 * pitch + 8 * (lane & 7);
        const size_t js = (size_t)8 * rr * pitch;
#pragma unroll
        for (int j = 0; j < 4; ++j) { bk[j] = *(const u32x4*)(kp + j * js); bv[j] = *(const u32x4*)(vp + j * js); }
    } else {
#pragma unroll
        for (int j = 0; j < 8; ++j) {
            const int fu = f0 + 4 * j + (lane >> 4); const int fk = fu > fmax ? fmax : fu;
            const int R = c + rr * fk; const bool lo = R < L;
            const size_t off = (size_t)(lo ? R : R - 8) * pitch + 4 * (lane & 15);
            rk[j] = *(const f32x4*)((lo ? (const float*)kb0 : (const float*)kb1) + off);
            rv[j] = *(const f32x4*)((lo ? (const float*)vb0 : (const float*)vb1) + off);
        }
    }
}

template <bool F32>
DI void attn_core(const bf16_t* ZQ, int qrow, int qcol, int qf, int W,
                  const void* kb0, const void* kb1, const void* vb0, const void* vb1, int pitch, int L, int c, int rr, int fmax, int kf0, int nch, int cpy,
                  LAS unsigned char* klds, int lane, float& m_out, float& l_out, f32x16& O0, f32x16& O1) {
    const int r = lane & 31, h = lane >> 5;
    LAS unsigned char* vlds = klds + 4608;
    bf16x8 qfr[4];
    { const bf16_t* qp = ZQ + (size_t)qrow * 1024 + qcol + 8 * h;
#pragma unroll
      for (int st = 0; st < 4; ++st) qfr[st] = *(const bf16x8*)(qp + 16 * st); }
    float m = NEGBIG, l = 0.f;
#pragma unroll
    for (int i = 0; i < 16; ++i) { O0[i] = 0.f; O1[i] = 0.f; }
    const int i16 = lane & 15;
    const LAS unsigned char* vrd = vlds + (4 * h + (i16 >> 2)) * 144 + (16 * ((lane >> 4) & 1) + 4 * (i16 & 3)) * 2;
    const LAS unsigned char* krd = klds + r * 144 + 16 * h;
    const int wof = F32 ? (lane >> 4) * 144 + (lane & 15) * 8 : (lane >> 3) * 144 + (lane & 7) * 16;
    f32x4 rk[8], rv[8]; u32x4 bk[4], bv[4];
    int ch = 0;
    while (ch < nch && kf0 + 32 * ch + 31 < 0) ++ch;
    if (ch < nch) load_chunk<F32>(rk, rv, bk, bv, kf0 + 32 * ch, kb0, kb1, vb0, vb1, pitch, L, c, rr, fmax, lane);
    for (; ch < nch; ++ch) {
        const int f0 = kf0 + 32 * ch;
        if (!F32) {
#pragma unroll
            for (int j = 0; j < 4; ++j) { *(LAS u32x4*)(klds + wof + j * 8 * 144) = bk[j]; *(LAS u32x4*)(vlds + wof + j * 8 * 144) = bv[j]; }
        } else {
#pragma unroll
            for (int j = 0; j < 8; ++j) { *(LAS u32x2*)(klds + wof + j * 4 * 144) = pack4(rk[j]); *(LAS u32x2*)(vlds + wof + j * 4 * 144) = pack4(rv[j]); }
            if (cpy) {
#pragma unroll
                for (int j = 0; j < 8; ++j) {
                    const int fu = f0 + 4 * j + (lane >> 4); const int R = c + rr * fu;
                    const bool w = (fu <= fmax) && (R >= 8) && (R < 2048) && (cpy == 1 || (R >= 1536 && (R & 15) >= 8));
                    if (w) { const size_t off = (size_t)(R - 8) * pitch + 4 * (lane & 15);
                        __builtin_nontemporal_store(rk[j], (f32x4*)((float*)kb1 + off)); __builtin_nontemporal_store(rv[j], (f32x4*)((float*)vb1 + off)); }
                }
            }
        }
        if (ch + 1 < nch) load_chunk<F32>(rk, rv, bk, bv, f0 + 32, kb0, kb1, vb0, vb1, pitch, L, c, rr, fmax, lane);
        bf16x8 kfr[4];
#pragma unroll
        for (int st = 0; st < 4; ++st) kfr[st] = *(const LAS bf16x8*)(krd + 32 * st);
        f32x16 S;
#pragma unroll
        for (int i = 0; i < 16; ++i) S[i] = 0.f;
#pragma unroll
        for (int st = 0; st < 4; ++st) S = MFMA32(kfr[st], qfr[st], S);
        float mx = NEGBIG;
#pragma unroll
        for (int i = 0; i < 16; ++i) {
            const int f = f0 + (i & 3) + 8 * (i >> 2) + 4 * h;
            const int dist = qf - f;
            const bool ok = (f >= 0) && ((unsigned)dist <= (unsigned)W);
            S[i] = ok ? S[i] : NEGBIG;
            mx = fmaxf(mx, S[i]);
        }
        mx = fmaxf(mx, __shfl_xor(mx, 32));
        const float mn = fmaxf(m, mx);
        const float alpha = ex2(m - mn);
        m = mn;
        float rs = 0.f;
#pragma unroll
        for (int i = 0; i < 16; ++i) { S[i] = ex2(S[i] - mn); rs += S[i]; }
        rs += __shfl_xor(rs, 32);
        l = l * alpha + rs;
#pragma unroll
        for (int i = 0; i < 16; ++i) { O0[i] *= alpha; O1[i] *= alpha; }
        u32x4 p0, p1;
        p0.x = pk(S[0], S[1]); p0.y = pk(S[2], S[3]); p0.z = pk(S[4], S[5]); p0.w = pk(S[6], S[7]);
        p1.x = pk(S[8], S[9]); p1.y = pk(S[10], S[11]); p1.z = pk(S[12], S[13]); p1.w = pk(S[14], S[15]);
        const bf16x8 pf0 = __builtin_bit_cast(bf16x8, p0), pf1 = __builtin_bit_cast(bf16x8, p1);
        bf16x8 vf[2][2];
#pragma unroll
        for (int dt = 0; dt < 2; ++dt)
#pragma unroll
            for (int s = 0; s < 2; ++s) {
                const s16x4 lo = vtr(vrd + (16 * s) * 144 + 64 * dt), hi = vtr(vrd + (16 * s + 8) * 144 + 64 * dt);
                vf[dt][s] = __builtin_shufflevector(lo, hi, 0, 1, 2, 3, 4, 5, 6, 7);
            }
        O0 = MFMA32(vf[0][0], pf0, O0); O0 = MFMA32(vf[0][1], pf1, O0);
        O1 = MFMA32(vf[1][0], pf0, O1); O1 = MFMA32(vf[1][1], pf1, O1);
    }
    m_out = m; l_out = l;
}

#define XB_TMO      128
#define XB_XCNT(j)  (256  + 64 * (j))
#define XB_XSUB(j)  (1280 + 64 * (j))
#define XB_XGEN(j)  (2304 + 64 * (j))
#define XB_TOP      3328
#define XB_TOPGEN   3392
#define XCD_BAR_WORDS 3456
#define XB_SPIN_CAP (1u << 18)

__device__ __forceinline__ unsigned xb_ld(unsigned* p)              { return __hip_atomic_load(p, __ATOMIC_RELAXED, __HIP_MEMORY_SCOPE_AGENT); }
__device__ __forceinline__ unsigned xb_add(unsigned* p, unsigned v) { return __hip_atomic_fetch_add(p, v, __ATOMIC_RELAXED, __HIP_MEMORY_SCOPE_AGENT); }
__device__ __forceinline__ unsigned xb_xcc_id() { return (unsigned)__builtin_amdgcn_s_getreg((3 << 11) | 20) & 0xFu; }
#define XB_SPIN(cond, bar) do { unsigned _sp = 0; while (cond) { __builtin_amdgcn_s_sleep(1); \
    if ((++_sp & 255u) == 0u) { if (xb_ld(&(bar)[XB_TMO])) break; if (_sp > XB_SPIN_CAP) { atomicAdd(&(bar)[XB_TMO], 1u); break; } } } } while (0)

struct XcdBarrier {
    unsigned* bar; unsigned x;
    volatile LAS unsigned* st;
};

__device__ __forceinline__ XcdBarrier xcd_barrier_post(unsigned* bar, volatile LAS unsigned* st) {
    XcdBarrier b; b.bar = bar; b.x = xb_xcc_id(); b.st = st;
    if (threadIdx.x == 0) (void)xb_add(&bar[XB_XCNT(b.x)], 1u);
    return b;
}
__device__ __forceinline__ void xcd_barrier_complete(unsigned* bar, unsigned x, unsigned& nloc, unsigned& nx) {
    const unsigned G = gridDim.x * gridDim.y * gridDim.z;
    unsigned sum, cnt, mine, sp = 0u;
    for (;;) {
        sum = 0u; cnt = 0u; mine = 0u;
#pragma unroll
        for (unsigned j = 0; j < 16; ++j) { const unsigned c = xb_ld(&bar[XB_XCNT(j)]); sum += c; cnt += (c > 0u) ? 1u : 0u; mine = (j == x) ? c : mine; }
        if (sum == G) break;
        __builtin_amdgcn_s_sleep(1);
        if ((++sp & 255u) == 0u) { if (xb_ld(&bar[XB_TMO])) break; if (sp > XB_SPIN_CAP) { atomicAdd(&bar[XB_TMO], 1u); break; } }
    }
    nloc = mine > 0u ? mine : 1u; nx = cnt > 0u ? cnt : 1u;
}

__device__ __forceinline__ void xcd_barrier(const XcdBarrier& b) {
    asm volatile("s_waitcnt vmcnt(0)" ::: "memory");
    __syncthreads();
    if (threadIdx.x == 0) {
        unsigned* bar = b.bar;
        __builtin_amdgcn_s_waitcnt(0);
        unsigned nloc = b.st[0], nx = b.st[1];
        if (nloc == 0u) { xcd_barrier_complete(bar, b.x, nloc, nx); b.st[0] = nloc; b.st[1] = nx; }
        const unsigned old = xb_add(&bar[XB_XSUB(b.x)], 1u);
        const unsigned gen = old / nloc;
        if (old + 1u == (gen + 1u) * nloc) {
            __builtin_amdgcn_fence(__ATOMIC_RELEASE, "agent");
            asm volatile("s_waitcnt vmcnt(0)" ::: "memory");
            const unsigned og = xb_add(&bar[XB_TOP], 1u);
            const unsigned tg = og / nx;
            if (og + 1u == (tg + 1u) * nx) xb_add(&bar[XB_TOPGEN], 1u);
            else XB_SPIN(xb_ld(&bar[XB_TOPGEN]) == tg, bar);
            __builtin_amdgcn_fence(__ATOMIC_ACQUIRE, "agent");
            xb_add(&bar[XB_XGEN(b.x)], 1u);
            asm volatile("s_waitcnt vmcnt(0)" ::: "memory");
        } else {
            XB_SPIN(xb_ld(&bar[XB_XGEN(b.x)]) == gen, bar);
            __builtin_amdgcn_fence(__ATOMIC_ACQUIRE, "agent");
            asm volatile("s_waitcnt vmcnt(0)" ::: "memory");
        }
    }
    __syncthreads();
}

struct BgCopy { const float* src; float* dst; };
DI void bg_copy_all(const BgCopy& B, int wave, int) {
    const int lane = (int)__builtin_amdgcn_mbcnt_hi(~0u, __builtin_amdgcn_mbcnt_lo(~0u, 0u));
    const f32x4* sp = (const f32x4*)B.src + lane + (size_t)wave * 768; f32x4* dp = (f32x4*)B.dst + lane + (size_t)wave * 768;
    const int nk = (255 - wave + 7) >> 3;
    for (int q = 0; q < 8; ++q) {
        f32x4 t[48];
#pragma unroll
        for (int cc = 0; cc < 4; ++cc) { const int j = 4 * q + cc; const f32x4* s_ = sp + (size_t)(j < nk ? j : nk - 1) * 6144;
#pragma unroll
            for (int i = 0; i < 12; ++i) t[12 * cc + i] = __builtin_nontemporal_load(s_ + 64 * i); }
#pragma unroll
        for (int cc = 0; cc < 4; ++cc) { const int j = 4 * q + cc; if (j < nk) { f32x4* d_ = dp + (size_t)j * 6144;
#pragma unroll
            for (int i = 0; i < 12; ++i) __builtin_nontemporal_store(t[12 * cc + i], d_ + 64 * i); } }
    }
}
template <class Base> struct SchedBg {
    Base base; BgCopy bg; int wave, lane, my_round; mutable int idx;
    DI bool next(int i, Unit& u) const { return base.next(i, u); }
    DI void a_ready(const Unit&) const {}
    DI void done(const Unit&) const { if (idx++ == my_round) bg_copy_all(bg, wave, lane); }
};

struct Params { const float* in[20]; float* out; unsigned char* ws; };
DI void norm_row(const float* xp, const float* xs, const float* mp, const float* gpre, bf16_t* AALL, int row, int lane) {
    const float* xr = row < NP ? xp + (size_t)row * 1024 : (row < NT ? xs + (size_t)(row - NP) * 1024 : mp + (size_t)(row - NT) * 1024);
    f32x4 v[4]; float s = 0.f;
#pragma unroll
    for (int j = 0; j < 4; ++j) { v[j] = ((const f32x4*)xr)[lane + 64 * j]; s += (v[j][0] * v[j][0] + v[j][1] * v[j][1]) + (v[j][2] * v[j][2] + v[j][3] * v[j][3]); }
    if (row < NT) {
        s = wave_sum(s); const float rstd = 1.0f / sqrtf(s * (1.f / 1024.f) + EPS);
#pragma unroll
        for (int j = 0; j < 4; ++j) { const f32x4 g = ((const f32x4*)gpre)[lane + 64 * j]; v[j] = v[j] * rstd * g; }
    }
#pragma unroll
    for (int j = 0; j < 4; ++j) *(u32x2*)(AALL + (size_t)row * 1024 + 4 * lane + 256 * j) = pack4(v[j]);
}
struct SchedX {
    int c;
    DI bool next(int i, Unit& u) const {
        if (i != 0) return false;
        if (c < 32) { u.pm = 64 + (c >> 3); u.pn = c & 7; } else { const int e = c - 32; u.pm = 68 + (e >> 1); u.pn = 8 + (e & 1); }
        u.ks = 0; u.kt = 0; return true;
    }
    DI void a_ready(const Unit&) const {}
    DI void done(const Unit&) const {}
};


constexpr int U_SB2 = 128 * 6 * 8, U_SB1 = 128 * 6 * 4, U_SB0 = 128 * 6, U_SA = 128 * 2, U_SX = 128 * 4;
constexpr int U_PB = 4 * 6 * 3 * 128, U_PA = 4 * 6 * 128, U_PX = 4 * 4 * 128;
constexpr int U_S_END = U_SB2 + U_SB1 + U_SB0 + U_SA + U_SX;
constexpr int U_TOTAL = U_S_END + U_PB + U_PA + U_PX;

DI void attn_unit(const Params& p, int uid, int lane, LAS unsigned char* vlds) {
    unsigned char* ws = p.ws;
    const bf16_t* ZQ = (const bf16_t*)(ws + WS_ZQ);
    bf16_t* CAT = (bf16_t*)(ws + WS_CAT);
    bf16_t* BPO = (bf16_t*)(ws + WS_BPO);
    f32x2_t* BPM = (f32x2_t*)(ws + WS_BPM);
    const int r = lane & 31, h = lane >> 5;
    bool qvalid = true; int qrow = 0, qcol = 0, qf = 0, head = 0;
    int mode = 0  , pi = 0, W = 128, pitch = 0, L = 0, c = 0, rr = 1, fmax = 0, kf0 = 0, nch = 5;
    const void *kb0 = nullptr, *kb1 = nullptr, *vb0 = nullptr, *vb1 = nullptr;
    int cpy = 0;
    float m, l; f32x16 O0, O1;
    if (uid < U_S_END) {
        int u;
        { const int n_ = uid / 84, lo_ = uid - n_ * 84;
          u = lo_ < 48 ? n_ * 48 + lo_ : (lo_ < 72 ? U_SB2 + n_ * 24 + (lo_ - 48) : (lo_ < 78 ? U_SB2 + U_SB1 + n_ * 6 + (lo_ - 72) : (lo_ < 80 ? U_SB2 + U_SB1 + U_SB0 + n_ * 2 + (lo_ - 78) : U_SB2 + U_SB1 + U_SB0 + U_SA + n_ * 4 + (lo_ - 80)))); }
        if (u < U_SB2 + U_SB1 + U_SB0) {
            int n, hd, i0, nq, istep;
            if (u < U_SB2) { pi = 2; rr = 16; c = u & 7; hd = (u >> 3) % 6; n = u / 48; nq = 1; i0 = c; istep = 0; qf = 128; kf0 = 0; fmax = (2055 - c) >> 4; }
            else if (u < U_SB2 + U_SB1) { u -= U_SB2; pi = 1; rr = 4; c = u & 3; hd = (u >> 2) % 6; n = u / 24; nq = 2; i0 = c; istep = 4; qf = 512 + r; kf0 = 384; fmax = (2055 - c) >> 2; }
            else { u -= U_SB2 + U_SB1; pi = 0; rr = 1; c = 0; hd = u % 6; n = u / 6; nq = 8; i0 = 0; istep = 1; qf = 2048 + r; kf0 = 1920; fmax = 2055; }
            qvalid = r < nq; const int rq = qvalid ? r : 0;
            if (!qvalid) qf = (pi == 2) ? 128 : (pi == 1 ? 512 : 2048);
            qrow = NP + n * 8 + i0 + istep * rq; head = hd; qcol = 384 + hd * 64; mode = 2;
            pitch = 384; L = 2048;
            kb0 = p.in[4] + (size_t)n * 2048 * 384 + hd * 64; vb0 = p.in[5] + (size_t)n * 2048 * 384 + hd * 64;
            kb1 = p.out + O_SDK + (size_t)n * 2048 * 384 + hd * 64; vb1 = p.out + O_SDV + (size_t)n * 2048 * 384 + hd * 64;
            cpy = pi == 2 ? 1 : (pi == 1 ? 2 : 0);
        } else if (u < U_SB2 + U_SB1 + U_SB0 + U_SA) {
            u -= U_SB2 + U_SB1 + U_SB0;
            const int kvh = u & 1, n = u >> 1;
            qvalid = r < 24; const int rq = qvalid ? r : 0;
            head = kvh * 3 + (rq >> 3); qrow = NP + n * 8 + (rq & 7); qcol = head * 64; qf = 128 + (rq & 7); mode = 1;
            pitch = 128; L = 128; kf0 = 0; fmax = 135;
            kb0 = p.in[2] + (size_t)n * 128 * 128 + kvh * 64; vb0 = p.in[3] + (size_t)n * 128 * 128 + kvh * 64;
            kb1 = p.out + O_SSK + (size_t)n * 128 * 128 + kvh * 64; vb1 = p.out + O_SSV + (size_t)n * 128 * 128 + kvh * 64;
        } else {
            u -= U_SB2 + U_SB1 + U_SB0 + U_SA;
            const int hd = u & 3, n = u >> 2;
            qvalid = r < 8; const int rq = qvalid ? r : 0;
            head = hd; qrow = NP + n * 8 + rq; qcol = 768 + hd * 64; qf = 1 << 20; W = 1 << 30; mode = 0;
            pitch = 256; L = 1 << 20; kf0 = 0; fmax = 255; nch = 8;
            kb0 = p.in[6] + (size_t)n * 256 * 256 + hd * 64; vb0 = p.in[7] + (size_t)n * 256 * 256 + hd * 64; kb1 = kb0; vb1 = vb0;
        }
        attn_core<true>(ZQ, qrow, qcol, qf, W, kb0, kb1, vb0, vb1, pitch, L, c, rr, fmax, kf0, nch, cpy, vlds, lane, m, l, O0, O1);
    } else {
        int u = uid - U_S_END;
        if (u < U_PB) {
            const int idx = u & 127; int t = u >> 7; pi = t % 3; t /= 3; const int hd = t % 6, b = t / 6;
            rr = pi == 0 ? 1 : (pi == 1 ? 4 : 16);
            const int tiles = 128 / rr; c = idx / tiles; const int ft = idx % tiles;
            qf = 32 * ft + r; qrow = b * 4096 + c + rr * qf; head = hd; qcol = 384 + hd * 64; mode = 2;
            pitch = 384; kf0 = 32 * ft - 128; fmax = 4096 / rr - 1;
            kb0 = (const bf16_t*)(ws + WS_KB) + (size_t)b * 4096 * 384 + hd * 64; vb0 = (const bf16_t*)(ws + WS_VB) + (size_t)b * 4096 * 384 + hd * 64;
        } else if (u < U_PB + U_PA) {
            u -= U_PB;
            const int tile = u & 127; const int t = u >> 7; const int hd = t % 6, b = t / 6, kvh = hd / 3;
            qf = 32 * tile + r; qrow = b * 4096 + qf; head = hd; qcol = hd * 64; mode = 1;
            pitch = 128; kf0 = 32 * tile - 128; fmax = 4095;
            kb0 = (const bf16_t*)(ws + WS_KA) + (size_t)b * 4096 * 128 + kvh * 64; vb0 = (const bf16_t*)(ws + WS_VA) + (size_t)b * 4096 * 128 + kvh * 64;
        } else {
            u -= U_PB + U_PA;
            const int tile = u & 127; const int t = u >> 7; const int hd = t & 3, b = t >> 2;
            qrow = b * 4096 + 32 * tile + r; head = hd; qcol = 768 + hd * 64; qf = 1 << 20; W = 1 << 30; mode = 0;
            pitch = 256; kf0 = 0; fmax = 255; nch = 8;
            kb0 = (const bf16_t*)(ws + WS_MK) + (size_t)b * 256 * 256 + hd * 64; vb0 = (const bf16_t*)(ws + WS_MV) + (size_t)b * 256 * 256 + hd * 64;
        }
        attn_core<false>(ZQ, qrow, qcol, qf, W, kb0, kb0, vb0, vb0, pitch, 1 << 30, c, rr, fmax, kf0, nch, 0, vlds, lane, m, l, O0, O1);
    }
    float scale;
    if (mode == 1) { const float s2 = p.in[11][head] * LOG2E; const float mm = fmaxf(m, s2); const float a = ex2(m - mm); scale = a / (l * a + ex2(s2 - mm)); }
    else scale = 1.f / l;
    if (qvalid) {
        bf16_t* dst = (mode == 2) ? BPO + ((size_t)pi * NT + qrow) * 384 + head * 64 : CAT + (size_t)qrow * 1024 + qcol;
#pragma unroll
        for (int i4 = 0; i4 < 4; ++i4) {
            f32x4 a = {O0[4 * i4] * scale, O0[4 * i4 + 1] * scale, O0[4 * i4 + 2] * scale, O0[4 * i4 + 3] * scale};
            f32x4 b = {O1[4 * i4] * scale, O1[4 * i4 + 1] * scale, O1[4 * i4 + 2] * scale, O1[4 * i4 + 3] * scale};
            *(u32x2*)(dst + 8 * i4 + 4 * h) = pack4(a);
            *(u32x2*)(dst + 32 + 8 * i4 + 4 * h) = pack4(b);
        }
        if (mode == 2 && h == 0) { f32x2_t ml = {m, l}; BPM[((size_t)pi * NT + qrow) * 6 + head] = ml; }
    }
}

__global__ void __launch_bounds__(512, 2) fwd_kernel(Params p) {
    extern __shared__ __attribute__((aligned(16))) unsigned char lds_raw[];
    LAS unsigned char* lds = (LAS unsigned char*)lds_raw;
    cg::grid_group grid = cg::this_grid();
    const int tid = threadIdx.x, lane = tid & 63, wave = __builtin_amdgcn_readfirstlane(tid >> 6);
    const int G = gridDim.x, gw = blockIdx.x * 8 + wave, NGW = G * 8, gt = blockIdx.x * 512 + tid, NGT = G * 512;
    unsigned char* ws = p.ws;
    bf16_t* WIN = (bf16_t*)(ws + WS_WIN); bf16_t* WO = (bf16_t*)(ws + WS_WO); bf16_t* WGU = (bf16_t*)(ws + WS_WGU); bf16_t* WD = (bf16_t*)(ws + WS_WD);
    bf16_t* AALL = (bf16_t*)(ws + WS_AALL); bf16_t* CAT = (bf16_t*)(ws + WS_CAT); bf16_t* TB = (bf16_t*)(ws + WS_T); bf16_t* ACT = (bf16_t*)(ws + WS_ACT);
    float* SS = (float*)(ws + WS_SS); float* PART = (float*)(ws + WS_PART); f32x2_t* ROT = (f32x2_t*)(ws + WS_ROT);
    float* Y = p.out + O_Y; bf16_t* X1B = (bf16_t*)(ws + WS_BPO);
    if (tid < 64) ((LAS unsigned*)(lds + 131072))[tid] = 0u;
    __syncthreads();
    const XcdBarrier xbar = xcd_barrier_post((unsigned*)(ws + WS_CTL) + 1024, (volatile LAS unsigned*)(lds + 131072));

    {
        LAS float* scr = (LAS float*)(lds + wave * 16384);
        constexpr int I_IN = 16 * 64, I_MEM = 16 * 16;
        for (int it = gw; it < I_IN + I_MEM; it += NGW) {
            if (it < I_IN) tr_item<1>(p.in[10], nullptr, 1024, 2048, 2048, WIN, 0, scr, it, lane);
            else tr_item<1>(p.in[12], nullptr, 1024, 512, 512, WIN, 2048, scr, it - I_IN, lane);
        }
        for (int row = NP + gw; row < NT + 1024; row += NGW) norm_row(p.in[0], p.in[1], p.in[8], p.in[9], AALL, row, lane);
        for (int idx = gt; idx < 4104 * 32; idx += NGT) {
            const int pp = idx >> 5, i = idx & 31; const int pos = pp < 4096 ? pp : 16384 + (pp - 4096);
            double rev = (double)pos * INVF[i] * 0.15915494309189535; rev -= __builtin_rint(rev);
            const float fr = (float)rev;
            f32x2_t cs = {__builtin_amdgcn_cosf(fr), __builtin_amdgcn_sinf(fr)};
            ROT[idx] = cs;
        }
    }
    if (p.ws == nullptr) grid.sync();
    xcd_barrier(xbar);

    constexpr int NXB = 40;
    if ((int)blockIdx.x < NXB) {
        Gemm g{AALL, WIN, NT + 1024, 2560, 1024};
        SchedX S; S.c = (int)blockIdx.x;
        EpiQKV E{ws, p.out, (const f32x4*)ROT};
        gemm_phase<EpiQKV, SchedX, true, true>(lds, g, S, E);
    } else {
        LAS float* scr = (LAS float*)(lds + wave * 16384);
        const int gw2 = ((int)blockIdx.x - NXB) * 8 + wave, NGW2 = (G - NXB) * 8, gt2 = ((int)blockIdx.x - NXB) * 512 + tid, NGT2 = (G - NXB) * 512;
        constexpr int I_O = 16 * 32, I_GU = 16 * 176, I_D = 44 * 32;
        for (int it = gw2; it < I_O + I_GU + I_D; it += NGW2) {
            int r = it;
            if (r < I_O) { tr_item<0>(p.in[13], nullptr, 1024, 1024, 1024, WO, 0, scr, r, lane); continue; } r -= I_O;
            if (r < I_GU) { tr_item<2>(p.in[16], p.in[17], 1024, 5632, 2816, WGU, 0, scr, r, lane); continue; } r -= I_GU;
            tr_item<0>(p.in[18], nullptr, 2816, 1024, 1024, WD, 0, scr, r, lane);
        }
        for (int row = gw2; row < NP; row += 2 * NGW2) {
            const int row1 = row + NGW2; const bool has1 = row1 < NP;
            const f32x4* x0 = (const f32x4*)(p.in[0] + (size_t)row * 1024) + lane; const f32x4* x1p = (const f32x4*)(p.in[0] + (size_t)(has1 ? row1 : row) * 1024) + lane;
            f32x4 a[4], b[4], g[4]; float sa = 0.f, sb = 0.f;
#pragma unroll
            for (int j = 0; j < 4; ++j) { a[j] = x0[64 * j]; b[j] = x1p[64 * j]; g[j] = ((const f32x4*)p.in[9])[lane + 64 * j]; }
#pragma unroll
            for (int j = 0; j < 4; ++j) { sa += (a[j][0] * a[j][0] + a[j][1] * a[j][1]) + (a[j][2] * a[j][2] + a[j][3] * a[j][3]); sb += (b[j][0] * b[j][0] + b[j][1] * b[j][1]) + (b[j][2] * b[j][2] + b[j][3] * b[j][3]); }
            sa = wave_sum(sa); sb = wave_sum(sb);
            const float ra = 1.0f / sqrtf(sa * (1.f / 1024.f) + EPS), rb = 1.0f / sqrtf(sb * (1.f / 1024.f) + EPS);
#pragma unroll
            for (int j = 0; j < 4; ++j) *(u32x2*)(AALL + (size_t)row * 1024 + 4 * lane + 256 * j) = pack4(a[j] * ra * g[j]);
            if (has1) {
#pragma unroll
                for (int j = 0; j < 4; ++j) *(u32x2*)(AALL + (size_t)row1 * 1024 + 4 * lane + 256 * j) = pack4(b[j] * rb * g[j]);
            }
        }
        copy_shift(p.in[2], p.out + O_SSK, 120 * 128 / 4, 8 * 128, 128 * 128, gt2, NGT2);
        copy_shift(p.in[3], p.out + O_SSV, 120 * 128 / 4, 8 * 128, 128 * 128, gt2, NGT2);
    }
    xcd_barrier(xbar);

    {
        Gemm g{AALL, WIN, NT + 1024, 2560, 1024};
        StaticOrder S; S.init(NP, 2048, G, (int)blockIdx.x);
        EpiQKV E{ws, p.out, (const f32x4*)ROT};
        gemm_phase<EpiQKV, StaticOrder, true, true>(lds, g, S, E);
    }
    xcd_barrier(xbar);

    {
        LAS unsigned char* vlds = lds + wave * 9216;
        constexpr int NCU = 2 * 128 * 24;
        constexpr int NM = U_S_END + NCU, NC = U_TOTAL - U_S_END;
        for (int k = 0; k * NGW < (NM > NC ? NM : NC); ++k) {
            const int ui = gw + k * NGW;
            for (int half = 0; half < 2; ++half) {
                const bool doM = ((half ^ wave) & 1) == 0;
                int uid = -1, cu = -1;
                if (doM) {
                    if (ui < U_S_END) {
                        uid = ui;
                        if (G == 256) {
                            const int x_ = (int)blockIdx.x & 7, ux_ = ((int)blockIdx.x >> 3) * 8 + wave + 256 * k;
                            uid = ux_ < 1344 ? ((ux_ / 84) * 8 + x_) * 84 + ux_ % 84 : -1;
                        }
                    } else if (ui < NM) cu = ui - U_S_END;
                } else if (ui < NC) {
                    uid = U_S_END + ui;
                    if (G == 256) {
                        const int x_ = (int)blockIdx.x & 7, ux_ = ((int)blockIdx.x >> 3) * 8 + wave + 256 * k;
                        const int j_ = ux_ >> 7;
                        const int grp_ = j_ < 9 ? (x_ * 3 + j_ / 3) * 3 + j_ % 3 : (j_ < 12 ? 72 + (x_ >> 1) * 6 + (x_ & 1) * 3 + (j_ - 9) : 96 + x_ * 2 + (j_ - 12));
                        uid = U_S_END + grp_ * 128 + (ux_ & 127);
                    }
                }
                if (uid >= 0) attn_unit(p, uid, lane, vlds);
                else if (cu >= 0) {
                    const int tensor = cu & 1, n = (cu >> 1) & 127, g4 = cu >> 8;
                    const float* src = p.in[4 + tensor] + (size_t)n * 2048 * 384; float* dst = p.out + (tensor ? O_SDV : O_SDK) + (size_t)n * 2048 * 384;
                    for (int jh = 0; jh < 4; jh += 2) {
                        f32x4 t[2][12];
#pragma unroll
                        for (int j = 0; j < 2; ++j) { const f32x4* sp = (const f32x4*)(src + (size_t)(16 * (4 * g4 + jh + j) + 8) * 384) + lane;
#pragma unroll
                            for (int i = 0; i < 12; ++i) t[j][i] = __builtin_nontemporal_load(sp + 64 * i); }
#pragma unroll
                        for (int j = 0; j < 2; ++j) { f32x4* dp = (f32x4*)(dst + (size_t)(16 * (4 * g4 + jh + j)) * 384) + lane;
#pragma unroll
                            for (int i = 0; i < 12; ++i) __builtin_nontemporal_store(t[j][i], dp + 64 * i); }
                    }
                }
            }
        }
    }
    xcd_barrier(xbar);

    {
        const bf16_t* BPO = (const bf16_t*)(ws + WS_BPO); const f32x2_t* BPM = (const f32x2_t*)(ws + WS_BPM);
        for (int idx = gt; idx < NT * 48; idx += NGT) {
            const int ch = idx & 7, t = idx >> 3, head = t % 6, row = t / 6;
            f32x2_t ml[3];
#pragma unroll
            for (int i = 0; i < 3; ++i) ml[i] = BPM[((size_t)i * NT + row) * 6 + head];
            const float M = fmaxf(ml[0][0], fmaxf(ml[1][0], ml[2][0]));
            float w[3], den = 0.f;
#pragma unroll
            for (int i = 0; i < 3; ++i) { w[i] = ml[i][1] * ex2(ml[i][0] - M); den += w[i]; }
            const float inv = 1.f / den;
            f32x4 a = {0.f, 0.f, 0.f, 0.f}, b = {0.f, 0.f, 0.f, 0.f};
#pragma unroll
            for (int i = 0; i < 3; ++i) {
                const u32x4 v = *(const u32x4*)(BPO + ((size_t)i * NT + row) * 384 + head * 64 + 8 * ch);
                u32x2 lo = {v.x, v.y}, hi = {v.z, v.w};
                a += unpack4(lo) * (w[i] * inv); b += unpack4(hi) * (w[i] * inv);
            }
            *(bf16x8*)(CAT + (size_t)row * 1024 + 384 + head * 64 + 8 * ch) = pack8(a, b);
        }
    }
    xcd_barrier(xbar);

    {
        Gemm g{CAT, WO, NT, 1024, 1024};
        SchedSK S; S.init(G, (int)blockIdx.x, 1024);
        EpiT E{TB, SS, PART};
        gemm_phase<EpiT, SchedSK, true, true>(lds, g, S, E);
    }
    xcd_barrier(xbar);

    int p4_first = gw;
    if (NGW == 2048) {
        const int lane = fresh_lane();
        const int xr0 = 2048 * ((int)blockIdx.x & 7) + ((int)blockIdx.x >> 3) * 8 + wave;
        f32x4 g1[4], g2[4];
#pragma unroll
        for (int j = 0; j < 4; ++j) { g1[j] = ((const f32x4*)p.in[14])[lane + 64 * j]; g2[j] = ((const f32x4*)p.in[15])[lane + 64 * j]; }
        for (int k0 = 0; k0 < 8; k0 += 2) {
            u32x2 tb[2][4]; f32x4 xv[2][4]; float ssq[2];
#pragma unroll
            for (int i = 0; i < 2; ++i) {
                const int row = xr0 + (k0 + i) * 256;
#pragma unroll
                for (int j = 0; j < 4; ++j) { tb[i][j] = *(const u32x2*)(TB + (size_t)row * 1024 + 4 * lane + 256 * j); xv[i][j] = ((const f32x4*)(p.in[0] + (size_t)row * 1024))[lane + 64 * j]; }
                float a_ = 0.f;
#pragma unroll
                for (int s_ = 0; s_ < 16; ++s_) a_ += SS[(size_t)s_ * NT + row];
                ssq[i] = a_;
            }
            float s2[2];
#pragma unroll
            for (int i = 0; i < 2; ++i) {
                const int row = xr0 + (k0 + i) * 256;
                const float rstd = 1.0f / sqrtf(ssq[i] * (1.f / 1024.f) + EPS);
                float q_ = 0.f;
#pragma unroll
                for (int j = 0; j < 4; ++j) {
                    xv[i][j] = xv[i][j] + unpack4(tb[i][j]) * rstd * g1[j];
                    *(u32x2*)(X1B + (size_t)row * 1024 + 4 * lane + 256 * j) = pack4(xv[i][j]);
                    q_ += (xv[i][j][0] * xv[i][j][0] + xv[i][j][1] * xv[i][j][1]) + (xv[i][j][2] * xv[i][j][2] + xv[i][j][3] * xv[i][j][3]);
                }
                s2[i] = q_;
            }
            s2[0] = wave_sum(s2[0]); s2[1] = wave_sum(s2[1]);
#pragma unroll
            for (int i = 0; i < 2; ++i) {
                const int row = xr0 + (k0 + i) * 256;
                const float r2 = 1.0f / sqrtf(s2[i] * (1.f / 1024.f) + EPS);
#pragma unroll
                for (int j = 0; j < 4; ++j) *(u32x2*)(AALL + (size_t)row * 1024 + 4 * lane + 256 * j) = pack4(xv[i][j] * r2 * g2[j]);
            }
        }
        p4_first = gw + 8 * 2048;
    }
    for (int row = p4_first; row < NT; row += NGW) {
        const int lane = fresh_lane();
        float ss = 0.f; f32x4 tv[4];
        if (row < NP) {
#pragma unroll
            for (int s = 0; s < 16; ++s) ss += SS[(size_t)s * NT + row];
#pragma unroll
            for (int j = 0; j < 4; ++j) tv[j] = unpack4(*(const u32x2*)(TB + (size_t)row * 1024 + 4 * lane + 256 * j));
        } else {
#pragma unroll
            for (int j = 0; j < 4; ++j) tv[j] = (f32x4){0.f, 0.f, 0.f, 0.f};
            for (int s = 0; s < 4; ++s)
#pragma unroll
                for (int j = 0; j < 4; ++j) tv[j] += ((const f32x4*)(PART + ((size_t)s * 1024 + (row - NP)) * 1024))[lane + 64 * j];
#pragma unroll
            for (int j = 0; j < 4; ++j) ss += (tv[j][0] * tv[j][0] + tv[j][1] * tv[j][1]) + (tv[j][2] * tv[j][2] + tv[j][3] * tv[j][3]);
            ss = wave_sum(ss);
        }
        const float rstd = 1.0f / sqrtf(ss * (1.f / 1024.f) + EPS);
        const float* xr = row < NP ? p.in[0] + (size_t)row * 1024 : p.in[1] + (size_t)(row - NP) * 1024;
        f32x4 x1[4]; float s2 = 0.f;
#pragma unroll
        for (int j = 0; j < 4; ++j) {
            const f32x4 t = tv[j];
            const f32x4 g = ((const f32x4*)p.in[14])[lane + 64 * j];
            x1[j] = ((const f32x4*)xr)[lane + 64 * j] + t * rstd * g;
            *(u32x2*)(X1B + (size_t)row * 1024 + 4 * lane + 256 * j) = pack4(x1[j]);
            s2 += (x1[j][0] * x1[j][0] + x1[j][1] * x1[j][1]) + (x1[j][2] * x1[j][2] + x1[j][3] * x1[j][3]);
        }
        s2 = wave_sum(s2); const float r2 = 1.0f / sqrtf(s2 * (1.f / 1024.f) + EPS);
#pragma unroll
        for (int j = 0; j < 4; ++j) { const f32x4 g = ((const f32x4*)p.in[15])[lane + 64 * j]; *(u32x2*)(AALL + (size_t)row * 1024 + 4 * lane + 256 * j) = pack4(x1[j] * r2 * g); }
    }
    xcd_barrier(xbar);

    {
        Gemm g{AALL, WGU, NT, 5632, 1024};
        StaticOrder S; S.init(NT, 5632, G, (int)blockIdx.x);
        EpiAct E{ACT};
        gemm_phase<EpiAct, StaticOrder, true, true>(lds, g, S, E);
    }
    xcd_barrier(xbar);

    {
        Gemm g{ACT, WD, NT, 1024, DFF};
        SchedSK S; S.init(G, (int)blockIdx.x, DFF);
        EpiT E{TB, SS, PART};
        gemm_phase<EpiT, SchedSK, true, true>(lds, g, S, E);
    }
    xcd_barrier(xbar);

    int p7_first = gw;
    if (NGW == 2048) {
        const int lane = fresh_lane();
        const int xr0 = 2048 * ((int)blockIdx.x & 7) + ((int)blockIdx.x >> 3) * 8 + wave;
        f32x4 gq[4];
#pragma unroll
        for (int j = 0; j < 4; ++j) gq[j] = ((const f32x4*)p.in[19])[lane + 64 * j];
        for (int k0 = 0; k0 < 8; k0 += 4) {
            u32x2 tb[4][4], xb[4][4]; float ssq[4];
#pragma unroll
            for (int i = 0; i < 4; ++i) {
                const int row = xr0 + (k0 + i) * 256;
#pragma unroll
                for (int j = 0; j < 4; ++j) { tb[i][j] = *(const u32x2*)(TB + (size_t)row * 1024 + 4 * lane + 256 * j); xb[i][j] = *(const u32x2*)(X1B + (size_t)row * 1024 + 4 * lane + 256 * j); }
                float a_ = 0.f;
#pragma unroll
                for (int s_ = 0; s_ < 16; ++s_) a_ += SS[(size_t)s_ * NT + row];
                ssq[i] = a_;
            }
#pragma unroll
            for (int i = 0; i < 4; ++i) {
                const int row = xr0 + (k0 + i) * 256;
                const float rstd = 1.0f / sqrtf(ssq[i] * (1.f / 1024.f) + EPS);
#pragma unroll
                for (int j = 0; j < 4; ++j) ((f32x4*)(Y + (size_t)row * 1024))[lane + 64 * j] = unpack4(xb[i][j]) + unpack4(tb[i][j]) * rstd * gq[j];
            }
        }
        p7_first = gw + 8 * 2048;
    }
    for (int row = p7_first; row < NT; row += NGW) {
        const int lane = fresh_lane();
        float ss = 0.f; f32x4 tv[4];
        if (row < NP) {
#pragma unroll
            for (int s = 0; s < 16; ++s) ss += SS[(size_t)s * NT + row];
#pragma unroll
            for (int j = 0; j < 4; ++j) tv[j] = unpack4(*(const u32x2*)(TB + (size_t)row * 1024 + 4 * lane + 256 * j));
        } else {
#pragma unroll
            for (int j = 0; j < 4; ++j) tv[j] = (f32x4){0.f, 0.f, 0.f, 0.f};
            for (int s = 0; s < 11; ++s)
#pragma unroll
                for (int j = 0; j < 4; ++j) tv[j] += ((const f32x4*)(PART + ((size_t)s * 1024 + (row - NP)) * 1024))[lane + 64 * j];
#pragma unroll
            for (int j = 0; j < 4; ++j) ss += (tv[j][0] * tv[j][0] + tv[j][1] * tv[j][1]) + (tv[j][2] * tv[j][2] + tv[j][3] * tv[j][3]);
            ss = wave_sum(ss);
        }
        const float rstd = 1.0f / sqrtf(ss * (1.f / 1024.f) + EPS);
#pragma unroll
        for (int j = 0; j < 4; ++j) {
            const f32x4 t = tv[j];
            const f32x4 g = ((const f32x4*)p.in[19])[lane + 64 * j];
            const f32x4 x1v = unpack4(*(const u32x2*)(X1B + (size_t)row * 1024 + 4 * lane + 256 * j));
            ((f32x4*)(Y + (size_t)row * 1024))[lane + 64 * j] = x1v + t * rstd * g;
        }
    }
}

extern "C" void kernel_launch(void* const* d_in, const int* in_sizes, int n_in, void* d_out, int out_size, void* d_ws, size_t ws_size, hipStream_t stream) {
    static int grid_blocks = 0;
    if (!grid_blocks) {
        int dev = 0, cus = 0, per_cu = 0;
        (void)hipGetDevice(&dev);
        (void)hipDeviceGetAttribute(&cus, hipDeviceAttributeMultiprocessorCount, dev);
        if (hipFuncSetAttribute((const void*)fwd_kernel, hipFuncAttributeMaxDynamicSharedMemorySize, LDS_BYTES) != hipSuccess) fprintf(stderr, "hipFuncSetAttribute failed\n");
        if (hipOccupancyMaxActiveBlocksPerMultiprocessor(&per_cu, (const void*)fwd_kernel, 512, LDS_BYTES) != hipSuccess || per_cu < 1) { fprintf(stderr, "occupancy query: %d\n", per_cu); per_cu = 1; }
        (void)hipGetLastError();
        grid_blocks = cus;
        if (n_in != 20 || ws_size < WS_END) fprintf(stderr, "kernel_launch: unexpected n_in %d / ws_size %zu\n", n_in, ws_size);
    }
    (void)hipMemsetAsync((char*)d_ws + WS_CTL, 0, CTL_ZERO_BYTES, stream);
    Params p{};
    for (int i = 0; i < 20; ++i) p.in[i] = (const float*)d_in[i];
    p.out = (float*)d_out; p.ws = (unsigned char*)d_ws;
    void* args[] = {&p};
    hipError_t e = hipLaunchCooperativeKernel((const void*)fwd_kernel, dim3(grid_blocks), dim3(512), args, LDS_BYTES, stream);
    if (e != hipSuccess) fprintf(stderr, "cooperative launch failed: %s (grid %d)\n", hipGetErrorString(e), grid_blocks);
}
```

```cpp
#include <hip/hip_runtime.h>
#include <hip/hip_cooperative_groups.h>
#include <cstdio>
#include <cstdint>
namespace cg = cooperative_groups;
namespace pg8 {
#define PG8_LAS __attribute__((address_space(3)))
typedef unsigned short bf16_t;
typedef short bf16x8 __attribute__((ext_vector_type(8)));
typedef float f32x4 __attribute__((ext_vector_type(4)));
typedef unsigned u32x4 __attribute__((ext_vector_type(4)));
constexpr int BM = 256, BK = 64, HALF = 128, HTB = HALF * BK * 2  , STAGE_BYTES = 8 * HTB, NXCD = 8, WGM = 8;

__host__ __device__ __forceinline__ int lds_byte(int r, int c) { const int st = (r >> 4) * 2 + (c >> 5), rr = r & 15, cc = c & 31, ob = rr * 64 + cc * 2; return st * 1024 + (ob ^ (((ob >> 9) & 1) << 5)); }
__host__ __device__ __forceinline__ void stage_rc(int b, int& R, int& C) { const int st = b / 1024, sb = b % 1024, swz = sb ^ (((sb >> 9) & 1) << 5); R = (st >> 1) * 16 + swz / 64; C = (st & 1) * 32 + (swz % 64) / 2; }
__host__ __device__ __forceinline__ int perm32(int rho) { const int n = rho >> 4, i = rho & 15; return 8 * (i >> 2) + 4 * n + (i & 3); }

struct Unit { int pm, pn, ks, kt; };
struct Gemm { const bf16_t* A; const bf16_t* Bt; int M, N, K; };

struct StaticOrder {
    int nM, nN, nwg, G, c;
    __host__ __device__ void init(int M, int N, int G_, int c_) { nM = M / BM; nN = N / BM; nwg = nM * nN; G = G_; c = c_; }
    __host__ __device__ bool next(int i, Unit& u) const {
        const long L = (long)i * G + c; if (L >= nwg) return false;
        int wgid = (int)L; { const int q = nwg / NXCD, r = nwg % NXCD, xcd = wgid % NXCD, off = wgid / NXCD; wgid = (xcd < r ? xcd * (q + 1) : r * (q + 1) + (xcd - r) * q) + off; }
        const int nig = WGM * nN, gid = wgid / nig, fm = gid * WGM, gsz = (nM - fm) < WGM ? (nM - fm) : WGM;
        u.pm = fm + ((wgid % nig) % gsz); u.pn = (wgid % nig) / gsz; u.ks = 0; u.kt = 0; return true;
    }
    __device__ __forceinline__ void a_ready(const Unit&) const {}
    __device__ __forceinline__ void done(const Unit&) const {}
};

__device__ __forceinline__ unsigned cvt_pk_bf16(float lo, float hi) { unsigned r; asm volatile("v_cvt_pk_bf16_f32 %0, %1, %2" : "=v"(r) : "v"(lo), "v"(hi)); return r; }
template <class Epi, class Sched, bool ALIGN_EPI = false, bool SP2 = false>
__device__ __forceinline__ void gemm_phase(PG8_LAS unsigned char* lds, const Gemm g, const Sched& S, const Epi& E) {
    int tid_ = threadIdx.x; asm volatile("" : "+v"(tid_));
    const int tid = tid_, wid = __builtin_amdgcn_readfirstlane(tid >> 6), lane = tid & 63, wr = wid >> 2, wc = wid & 3, fr = lane & 15, fq = lane >> 4;
    const int K = g.K;
    unsigned voffA[2], voffB[2];
#pragma unroll
    for (int i = 0; i < 2; ++i) { int R, C; stage_rc(tid * 16 + i * 8192, R, C); const int Rb = Epi::PERM ? ((R & ~31) + perm32(R & 31)) : R;
        voffA[i] = (unsigned)(R * K + C) * 2u; voffB[i] = (unsigned)(Rb * K + C) * 2u; }
    const size_t kstep = (size_t)(BK * 2);
    const size_t hstep = (size_t)HALF * K * 2;
    const size_t tstep = 2 * hstep;
    const unsigned ldsw = (unsigned)wid * 1024u;
    const int aoff = lds_byte(wr * 64 + fr, fq * 8), boff = lds_byte(wc * 32 + fr, fq * 8);
#define PG8_SA(b, h) (((b) * 2 + (h)) * HTB)
#define PG8_SB(b, h) ((4 + (b) * 2 + (h)) * HTB)
#define PG8_STAGE(bufoff, gbase, voff) do { _Pragma("unroll") for (int _i = 0; _i < 2; ++_i) \
        __builtin_amdgcn_global_load_lds((const unsigned*)((const char*)(gbase) + (voff)[_i]), (PG8_LAS unsigned*)(lds + (bufoff) + ldsw + _i * 8192), 16, 0, 0); } while (0)
#define PG8_LDA(dst, b, h) do { _Pragma("unroll") for (int m = 0; m < 4; ++m) _Pragma("unroll") for (int k = 0; k < 2; ++k) dst[m][k] = *(const PG8_LAS bf16x8*)(lds + PG8_SA(b, h) + aoff + m * 2048 + k * 1024); } while (0)
#define PG8_LDB(dst, b, h) do { _Pragma("unroll") for (int n = 0; n < 2; ++n) _Pragma("unroll") for (int k = 0; k < 2; ++k) dst[n][k] = *(const PG8_LAS bf16x8*)(lds + PG8_SB(b, h) + boff + n * 2048 + k * 1024); } while (0)
#define PG8_MMA(ai, bj, At, Bt) do { __builtin_amdgcn_s_setprio(1); _Pragma("unroll") for (int m = 0; m < 4; ++m) _Pragma("unroll") for (int n = 0; n < 2; ++n) _Pragma("unroll") for (int k = 0; k < 2; ++k) \
        acc[ai][bj][m][n] = __builtin_amdgcn_mfma_f32_16x16x32_bf16(Bt[n][k], At[m][k], acc[ai][bj][m][n], 0, 0, 0); __builtin_amdgcn_s_setprio(0); } while (0)
#define PG8_WAIT_V(n) asm volatile("s_waitcnt vmcnt(" #n ")" ::: "memory")
#define PG8_WAIT_L(n) asm volatile("s_waitcnt lgkmcnt(" #n ")" ::: "memory")
#define PG8_BAR __builtin_amdgcn_s_barrier()
#define PG8_SCHED __builtin_amdgcn_sched_barrier(0)
    Unit cur, nxt; int ui = 0;
    if (!S.next(0, cur)) return;
    f32x4 acc[2][2][4][2];
#pragma unroll
    for (int a = 0; a < 2; ++a)
#pragma unroll
        for (int b = 0; b < 2; ++b)
#pragma unroll
            for (int m = 0; m < 4; ++m)
#pragma unroll
                for (int n = 0; n < 2; ++n) acc[a][b][m][n] = (f32x4){0.f, 0.f, 0.f, 0.f};
    bf16x8 At[4][2], B0[2][2], B1[2][2];
    const char* cA = (const char*)g.A + (size_t)cur.pm * tstep + (size_t)cur.ks * 2; const char* cB = (const char*)g.Bt + (size_t)cur.pn * tstep + (size_t)cur.ks * 2;
    S.a_ready(cur);
    if constexpr (SP2) {
        PG8_STAGE(PG8_SB(0, 0), cB, voffB); PG8_STAGE(PG8_SB(0, 1), cB + hstep, voffB); PG8_STAGE(PG8_SA(0, 0), cA, voffA); PG8_STAGE(PG8_SA(0, 1), cA + hstep, voffA);
        if (wr == 1) PG8_BAR;
        PG8_WAIT_V(2); PG8_BAR;
        PG8_STAGE(PG8_SB(1, 0), cB + kstep, voffB); PG8_STAGE(PG8_SA(1, 0), cA + kstep, voffA); PG8_STAGE(PG8_SB(1, 1), cB + hstep + kstep, voffB);
        PG8_WAIT_V(6); PG8_BAR;
    } else {
        PG8_STAGE(PG8_SB(0, 0), cB, voffB); PG8_STAGE(PG8_SA(0, 0), cA, voffA); PG8_STAGE(PG8_SB(0, 1), cB + hstep, voffB); PG8_STAGE(PG8_SA(0, 1), cA + hstep, voffA);
        if (wr == 1) PG8_BAR;
        PG8_WAIT_V(4); PG8_BAR;
        PG8_STAGE(PG8_SB(1, 0), cB + kstep, voffB); PG8_STAGE(PG8_SA(1, 0), cA + kstep, voffA); PG8_STAGE(PG8_SB(1, 1), cB + hstep + kstep, voffB);
        PG8_WAIT_V(6); PG8_BAR;
    }
    for (;;) {
        const bool has_next = S.next(ui + 1, nxt);
        const char* nA = has_next ? (const char*)g.A + (size_t)nxt.pm * tstep + (size_t)nxt.ks * 2 : cA; const char* nB = has_next ? (const char*)g.Bt + (size_t)nxt.pn * tstep + (size_t)nxt.ks * 2 : cB;
        const int nt = (cur.kt ? cur.kt : K) / BK;
        for (int t = 0; t < nt; t += 2) {
            const bool last = (t == nt - 2);
            const char* a1 = cA + (size_t)(t + 1) * kstep;
            const char* a2 = last ? nA : cA + (size_t)(t + 2) * kstep; const char* b2 = last ? nB : cB + (size_t)(t + 2) * kstep;
            const char* a3 = a2 + kstep; const char* b3 = b2 + kstep;
            if (last && has_next) S.a_ready(nxt);
            if constexpr (SP2) {
            PG8_LDB(B0, 0, 0); PG8_LDB(B1, 0, 1); PG8_SCHED; PG8_LDA(At, 0, 0); PG8_STAGE(PG8_SA(1, 1), a1 + hstep, voffA);
            PG8_WAIT_V(8); PG8_WAIT_L(0); PG8_BAR; PG8_MMA(0, 0, At, B0); PG8_MMA(0, 1, At, B1); PG8_BAR; PG8_SCHED;
            PG8_LDA(At, 0, 1); PG8_STAGE(PG8_SB(0, 0), b2, voffB); PG8_STAGE(PG8_SB(0, 1), b2 + hstep, voffB); PG8_STAGE(PG8_SA(0, 0), a2, voffA);
            PG8_WAIT_V(8); PG8_WAIT_L(0); PG8_BAR; PG8_MMA(1, 0, At, B0); PG8_MMA(1, 1, At, B1); PG8_BAR; PG8_SCHED;
            PG8_LDB(B0, 1, 0); PG8_LDB(B1, 1, 1); PG8_SCHED; PG8_LDA(At, 1, 0); PG8_STAGE(PG8_SA(0, 1), a2 + hstep, voffA);
            PG8_WAIT_V(8); PG8_WAIT_L(0); PG8_BAR; PG8_MMA(0, 0, At, B0); PG8_MMA(0, 1, At, B1); PG8_BAR; PG8_SCHED;
            PG8_LDA(At, 1, 1); PG8_STAGE(PG8_SB(1, 0), b3, voffB); PG8_STAGE(PG8_SB(1, 1), b3 + hstep, voffB); PG8_STAGE(PG8_SA(1, 0), a3, voffA);
            PG8_WAIT_V(8); PG8_WAIT_L(0); PG8_BAR; PG8_MMA(1, 0, At, B0); PG8_MMA(1, 1, At, B1); PG8_BAR; PG8_SCHED;
            } else {
            PG8_LDB(B0, 0, 0); PG8_SCHED; PG8_LDA(At, 0, 0); PG8_STAGE(PG8_SA(1, 1), a1 + hstep, voffA);
            PG8_WAIT_L(8); PG8_BAR; PG8_WAIT_L(0); PG8_MMA(0, 0, At, B0); PG8_BAR; PG8_SCHED;
            PG8_LDB(B1, 0, 1); PG8_STAGE(PG8_SB(0, 0), b2, voffB);
            PG8_BAR; PG8_WAIT_L(0); PG8_MMA(0, 1, At, B1); PG8_BAR;
            PG8_LDA(At, 0, 1); PG8_STAGE(PG8_SA(0, 0), a2, voffA);
            PG8_BAR; PG8_WAIT_L(0); PG8_MMA(1, 0, At, B0); PG8_BAR; PG8_SCHED;
            PG8_STAGE(PG8_SB(0, 1), b2 + hstep, voffB);
            PG8_WAIT_V(6); PG8_BAR; PG8_MMA(1, 1, At, B1); PG8_BAR;
            PG8_LDB(B0, 1, 0); PG8_SCHED; PG8_LDA(At, 1, 0); PG8_STAGE(PG8_SA(0, 1), a2 + hstep, voffA);
            PG8_WAIT_L(8); PG8_BAR; PG8_WAIT_L(0); PG8_MMA(0, 0, At, B0); PG8_BAR; PG8_SCHED;
            PG8_LDB(B1, 1, 1); PG8_STAGE(PG8_SB(1, 0), b3, voffB);
            PG8_BAR; PG8_WAIT_L(0); PG8_MMA(0, 1, At, B1); PG8_BAR;
            PG8_LDA(At, 1, 1); PG8_STAGE(PG8_SA(1, 0), a3, voffA);
            PG8_BAR; PG8_WAIT_L(0); PG8_MMA(1, 0, At, B0); PG8_BAR; PG8_SCHED;
            PG8_STAGE(PG8_SB(1, 1), b3 + hstep, voffB);
            PG8_WAIT_V(6); PG8_BAR; PG8_MMA(1, 1, At, B1); PG8_BAR;
            }
        }
        if constexpr (ALIGN_EPI) { if (wr == 0) PG8_BAR; }
        if constexpr (!Epi::AFTER_DRAIN) { E(acc, cur, wr, wc, fr, fq); S.done(cur); }
        if (!has_next) break;
#pragma unroll
        for (int a = 0; a < 2; ++a)
#pragma unroll
            for (int b = 0; b < 2; ++b)
#pragma unroll
                for (int m = 0; m < 4; ++m)
#pragma unroll
                    for (int n = 0; n < 2; ++n) acc[a][b][m][n] = (f32x4){0.f, 0.f, 0.f, 0.f};
        cur = nxt; cA = nA; cB = nB; ++ui;
        if constexpr (ALIGN_EPI) { if (wr == 1) PG8_BAR; }
    }
    PG8_WAIT_V(0);
    if constexpr (!ALIGN_EPI) { if (wr == 0) PG8_BAR; }
    PG8_BAR;
    if constexpr (Epi::AFTER_DRAIN) { E.fused(acc, cur, wr, wc, fr, fq, lds, wid, lane); S.done(cur); }
#undef PG8_SA
#undef PG8_SB
#undef PG8_STAGE
#undef PG8_LDA
#undef PG8_LDB
#undef PG8_MMA
#undef PG8_WAIT_V
#undef PG8_WAIT_L
#undef PG8_BAR
#undef PG8_SCHED
}
}

using namespace pg8;
#define LAS __attribute__((address_space(3)))
#define DI __device__ __forceinline__
typedef short s16x4 __attribute__((ext_vector_type(4)));
typedef short v4i16_t __attribute__((ext_vector_type(4)));
typedef float f32x16 __attribute__((ext_vector_type(16)));
typedef float f32x2_t __attribute__((ext_vector_type(2)));
typedef __bf16 bf16x2_t __attribute__((ext_vector_type(2)));
typedef unsigned u32x2 __attribute__((ext_vector_type(2)));

constexpr int NP = 16384, NS = 1024, NT = 17408, DM = 1024, DFF = 2816;
constexpr float EPS = 1e-6f;
constexpr float LOG2E = 1.4426950408889634f;
constexpr float QSCALE = 0.125f * LOG2E;
constexpr float NEGBIG = -1e30f;

constexpr size_t O_Y = 0;
constexpr size_t O_PSK = 17825792;
constexpr size_t O_PSV = 17891328;
constexpr size_t O_PDK = 17956864;
constexpr size_t O_PDV = 21102592;
constexpr size_t O_PMK = 24248320;
constexpr size_t O_PMV = 24510464;
constexpr size_t O_SSK = 24772608;
constexpr size_t O_SSV = 26869760;
constexpr size_t O_SDK = 28966912;
constexpr size_t O_SDV = 129630208;

constexpr size_t MiB = 1u << 20;
constexpr size_t WS_ROT = 1 * MiB;
constexpr size_t WS_WIN = 4 * MiB;
constexpr size_t WS_WO = 10 * MiB;
constexpr size_t WS_WGU = 12 * MiB;
constexpr size_t WS_WD = 24 * MiB;
constexpr size_t WS_AALL = 32 * MiB;
constexpr size_t WS_ZQ = 68 * MiB;
constexpr size_t WS_KA = 102 * MiB;
constexpr size_t WS_VA = 106 * MiB;
constexpr size_t WS_KB = 110 * MiB;
constexpr size_t WS_VB = 122 * MiB;
constexpr size_t WS_MK = 134 * MiB;
constexpr size_t WS_MV = 135 * MiB;
constexpr size_t WS_CAT = 136 * MiB;
constexpr size_t WS_BPO = 170 * MiB;
constexpr size_t WS_BPM = 210 * MiB;
constexpr size_t WS_T = 214 * MiB;
constexpr size_t WS_SS = 250 * MiB;
constexpr size_t WS_ACT = 252 * MiB;
constexpr size_t WS_PART = 348 * MiB;
constexpr size_t WS_END = 392 * MiB;

constexpr int LDS_BYTES = 131072 + 256;
constexpr size_t WS_CTL = 0, CTL_ZERO_BYTES = 65536;

__device__ const double INVF[32] = {
    1.0, 0.7498942093324559, 0.5623413251903491, 0.4216965034285822, 0.31622776601683794, 0.23713737056616552, 0.1778279410038923, 0.1333521432163324,
    0.1, 0.07498942093324558, 0.05623413251903491, 0.042169650342858224, 0.03162277660168379, 0.023713737056616554, 0.01778279410038923, 0.01333521432163324,
    0.01, 0.007498942093324558, 0.005623413251903491, 0.004216965034285823, 0.0031622776601683794, 0.0023713737056616554, 0.0017782794100389228, 0.001333521432163324,
    0.001, 0.0007498942093324559, 0.0005623413251903491, 0.00042169650342858224, 0.00031622776601683794, 0.00023713737056616554, 0.00017782794100389227, 0.0001333521432163324};

DI unsigned pk(float lo, float hi) { f32x2_t v = {lo, hi}; bf16x2_t b = __builtin_convertvector(v, bf16x2_t); return __builtin_bit_cast(unsigned, b); }
DI u32x2 pack4(f32x4 v) { u32x2 r; r.x = pk(v[0], v[1]); r.y = pk(v[2], v[3]); return r; }
DI bf16x8 pack8(f32x4 a, f32x4 b) { u32x4 r; r.x = pk(a[0], a[1]); r.y = pk(a[2], a[3]); r.z = pk(b[0], b[1]); r.w = pk(b[2], b[3]); return __builtin_bit_cast(bf16x8, r); }
DI f32x4 unpack4(u32x2 w) { f32x4 r; r[0] = __builtin_bit_cast(float, w.x << 16); r[1] = __builtin_bit_cast(float, w.x & 0xffff0000u); r[2] = __builtin_bit_cast(float, w.y << 16); r[3] = __builtin_bit_cast(float, w.y & 0xffff0000u); return r; }
DI float wave_sum(float v) {
#pragma unroll
    for (int o = 1; o < 64; o <<= 1) v += __shfl_xor(v, o);
    return v;
}
DI float ex2(float x) { return __builtin_amdgcn_exp2f(x); }
DI int fresh_lane() { return (int)__builtin_amdgcn_mbcnt_hi(~0u, __builtin_amdgcn_mbcnt_lo(~0u, 0u)); }

template <int MODE>
DI void tr_item(const float* W0, const float* W1, int K, int NV, int ld, bf16_t* WT, int row_off, LAS float* scr, int item, int lane) {
    const int nblk = NV / 32, kb = item / nblk, nb = item % nblk, k0 = 64 * kb, n0 = 32 * nb;
    const int v = n0 + (lane & 31);
    const float* src = W0; int col = v;
    if (MODE == 1) { const int hb = v >> 6, vv = v & 63; col = hb * 64 + ((vv >> 2) & 1) * 32 + (vv >> 3) * 4 + (vv & 3); }
    if (MODE == 2) { src = ((v >> 2) & 1) ? W1 : W0; col = (v >> 3) * 4 + (v & 3); }
    float tv_[32];
#pragma unroll
    for (int i = 0; i < 32; ++i) tv_[i] = src[(size_t)(k0 + 2 * i + (lane >> 5)) * ld + col];
#pragma unroll
    for (int i = 0; i < 32; ++i) scr[(2 * i + (lane >> 5)) * 33 + (lane & 31)] = tv_[i];
    asm volatile("s_waitcnt lgkmcnt(0)" ::: "memory");
    const int c = lane & 7;
#pragma unroll
    for (int j = 0; j < 4; ++j) { const int n = (lane >> 3) + 8 * j; const LAS float* s = scr + (8 * c) * 33 + n;
        u32x4 o; o.x = pk(s[0 * 33], s[1 * 33]); o.y = pk(s[2 * 33], s[3 * 33]); o.z = pk(s[4 * 33], s[5 * 33]); o.w = pk(s[6 * 33], s[7 * 33]);
        *(u32x4*)(WT + (size_t)(row_off + n0 + n) * K + k0 + 8 * c) = o; }
    asm volatile("s_waitcnt lgkmcnt(0)" ::: "memory");
}

DI void copy_shift(const float* src, float* dst, int nper, int srcoff, size_t stride, int gt, int NGT) {
    const int total = 128 * nper;
    for (int idx = gt; idx < total; idx += NGT) {
        const int n = idx / nper, o = idx - n * nper;
        const f32x4 v = __builtin_nontemporal_load((const f32x4*)(src + (size_t)n * stride + srcoff) + o);
        __builtin_nontemporal_store(v, (f32x4*)(dst + (size_t)n * stride) + o);
    }
}

struct Sched1 {
    StaticOrder so; int G, c;
    __device__ void init(int G_, int c_) { so.init(NT, 2048, G_, c_); G = G_; c = c_; }
    __device__ bool next(int i, Unit& u) const {
        const int L = i * G + c;
        if (L < 544) return so.next(i, u);
        if (L >= 552) return false;
        const int e = L - 544; u.pm = 68 + (e >> 1); u.pn = 8 + (e & 1); u.ks = 0; u.kt = 0; return true;
    }
    DI void a_ready(const Unit&) const {}
    DI void done(const Unit&) const {}
};

struct SchedSK {
    StaticOrder so; int c, nsl;
    __device__ void init(int G_, int c_, int K) { so.init(NP, 1024, G_, c_); c = c_; nsl = K / 256; }
    __device__ bool next(int i, Unit& u) const {
        if (i == 0) return so.next(0, u);
        if (i > 1 || c >= 16 * nsl) return false;
        const int tile = c / nsl, sl = c - tile * nsl;
        u.pm = 64 + (tile >> 2); u.pn = tile & 3; u.ks = sl * 256; u.kt = 256; return true;
    }
    DI void a_ready(const Unit&) const {}
    DI void done(const Unit&) const {}
};

struct EpiQKV {
    static constexpr bool PERM = true, AFTER_DRAIN = false;
    unsigned char* ws; float* out; const f32x4* rot;
    DI void operator()(const f32x4 (&acc)[2][2][4][2], const Unit& u, int wr, int wc, int fr, int fq) const {
        const int g4 = 4 * ((wc & 1) * 4 + fq), hsub = wc >> 1;
        if (u.pn < 8) {
#pragma unroll
            for (int ai = 0; ai < 2; ++ai)
#pragma unroll
                for (int m = 0; m < 4; ++m) {
                    const int row = u.pm * 256 + ai * 128 + wr * 64 + m * 16 + fr;
                    const bool samp = row >= NP;
                    const int ti = samp ? 4096 + (row & 7) : (row & 4095);
                    const f32x4 cs0 = rot[(ti * 32 + g4) >> 1], cs1 = rot[((ti * 32 + g4) >> 1) + 1];
#pragma unroll
                    for (int bj = 0; bj < 2; ++bj) {
                        const int cb = 2 * u.pn + bj;
                        f32x4 x1 = acc[ai][bj][m][0], x2 = acc[ai][bj][m][1];
                        const bool isrot = (cb <= 3) || (cb >= 5 && cb <= 10);
                        if (isrot) {
                            f32x4 o1, o2;
                            o1[0] = x1[0] * cs0[0] - x2[0] * cs0[1]; o2[0] = x2[0] * cs0[0] + x1[0] * cs0[1];
                            o1[1] = x1[1] * cs0[2] - x2[1] * cs0[3]; o2[1] = x2[1] * cs0[2] + x1[1] * cs0[3];
                            o1[2] = x1[2] * cs1[0] - x2[2] * cs1[1]; o2[2] = x2[2] * cs1[0] + x1[2] * cs1[1];
                            o1[3] = x1[3] * cs1[2] - x2[3] * cs1[3]; o2[3] = x2[3] * cs1[2] + x1[3] * cs1[3];
                            x1 = o1; x2 = o2;
                        }
                        if (cb <= 2 || (cb >= 5 && cb <= 7) || cb >= 14) {
                            const int col = cb <= 2 ? (2 * cb + hsub) * 64 : (cb <= 7 ? 384 + (2 * (cb - 5) + hsub) * 64 : 768 + (2 * (cb - 14) + hsub) * 64);
                            x1 = x1 * QSCALE; x2 = x2 * QSCALE;
                            bf16_t* dst = (bf16_t*)(ws + WS_ZQ) + (size_t)row * 1024 + col + g4;
                            *(u32x2*)dst = pack4(x1); *(u32x2*)(dst + 32) = pack4(x2);
                        } else {
                            const bool isA = cb <= 4; const bool isK = (cb == 3) || (cb >= 8 && cb <= 10);
                            const int head = isA ? hsub : (isK ? 2 * (cb - 8) + hsub : 2 * (cb - 11) + hsub);
                            const int nh = isA ? 2 : 6;
                            if (!samp) {
                                bf16_t* base = (bf16_t*)(ws + (isA ? (isK ? WS_KA : WS_VA) : (isK ? WS_KB : WS_VB)));
                                bf16_t* dst = base + (size_t)row * (nh * 64) + head * 64 + g4;
                                *(u32x2*)dst = pack4(x1); *(u32x2*)(dst + 32) = pack4(x2);
                                const int b = row >> 12, t = row & 4095, w0 = isA ? 3968 : 2048;
                                if (t >= w0) {
                                    float* o = out + (isA ? (isK ? O_PSK : O_PSV) : (isK ? O_PDK : O_PDV)) + ((size_t)(b * (4096 - w0) + (t - w0)) * nh + head) * 64 + g4;
                                    *(f32x4*)o = x1; *(f32x4*)(o + 32) = x2;
                                }
                            } else {
                                const int n = (row - NP) >> 3, i = row & 7, Lw = isA ? 128 : 2048;
                                float* o = out + (isA ? (isK ? O_SSK : O_SSV) : (isK ? O_SDK : O_SDV)) + ((size_t)(n * Lw + Lw - 8 + i) * nh + head) * 64 + g4;
                                *(f32x4*)o = x1; *(f32x4*)(o + 32) = x2;
                            }
                        }
                    }
                }
        } else {
#pragma unroll
            for (int ai = 0; ai < 2; ++ai)
#pragma unroll
                for (int m = 0; m < 4; ++m) {
                    const int row = (u.pm - 68) * 256 + ai * 128 + wr * 64 + m * 16 + fr;
#pragma unroll
                    for (int bj = 0; bj < 2; ++bj) {
                        const int cb = 2 * (u.pn - 8) + bj; const bool isK = cb < 2; const int head = 2 * (cb & 1) + hsub;
                        const f32x4 x1 = acc[ai][bj][m][0], x2 = acc[ai][bj][m][1];
                        bf16_t* dst = (bf16_t*)(ws + (isK ? WS_MK : WS_MV)) + (size_t)row * 256 + head * 64 + g4;
                        *(u32x2*)dst = pack4(x1); *(u32x2*)(dst + 32) = pack4(x2);
                        float* o = out + (isK ? O_PMK : O_PMV) + (size_t)row * 256 + head * 64 + g4;
                        *(f32x4*)o = x1; *(f32x4*)(o + 32) = x2;
                    }
                }
        }
    }
};

struct EpiT {
    static constexpr bool PERM = true, AFTER_DRAIN = false;
    bf16_t* T; float* SS; float* PART;
    DI void operator()(const f32x4 (&acc)[2][2][4][2], const Unit& u, int wr, int wc, int fr, int fq) const {
        if (u.kt) {
            float* P = PART + (size_t)(u.ks >> 8) * 1024 * 1024;
#pragma unroll
            for (int ai = 0; ai < 2; ++ai)
#pragma unroll
                for (int m = 0; m < 4; ++m) {
                    const int row = (u.pm - 64) * 256 + ai * 128 + wr * 64 + m * 16 + fr;
#pragma unroll
                    for (int bj = 0; bj < 2; ++bj) {
                        float* d = P + (size_t)row * 1024 + u.pn * 256 + bj * 128 + wc * 32 + fq * 8;
                        *(f32x4*)d = acc[ai][bj][m][0]; *(f32x4*)(d + 4) = acc[ai][bj][m][1];
                    }
                }
            return;
        }
#pragma unroll
        for (int ai = 0; ai < 2; ++ai)
#pragma unroll
            for (int m = 0; m < 4; ++m) {
                const int row = u.pm * 256 + ai * 128 + wr * 64 + m * 16 + fr;
                float s = 0.f;
#pragma unroll
                for (int bj = 0; bj < 2; ++bj) {
                    const f32x4 v0 = acc[ai][bj][m][0], v1 = acc[ai][bj][m][1];
                    s += (v0[0] * v0[0] + v0[1] * v0[1]) + (v0[2] * v0[2] + v0[3] * v0[3]) + (v1[0] * v1[0] + v1[1] * v1[1]) + (v1[2] * v1[2] + v1[3] * v1[3]);
                    u32x4 w; w.x = pk(v0[0], v0[1]); w.y = pk(v0[2], v0[3]); w.z = pk(v1[0], v1[1]); w.w = pk(v1[2], v1[3]);
                    *(u32x4*)(T + (size_t)row * 1024 + u.pn * 256 + bj * 128 + wc * 32 + fq * 8) = w;
                }
                s += __shfl_xor(s, 16); s += __shfl_xor(s, 32);
                if (fq == 0) SS[(size_t)(u.pn * 4 + wc) * NT + row] = s;
            }
    }
};

struct EpiAct {
    static constexpr bool PERM = true, AFTER_DRAIN = false;
    bf16_t* ACT;
    DI void operator()(const f32x4 (&acc)[2][2][4][2], const Unit& u, int wr, int wc, int fr, int fq) const {
#pragma unroll
        for (int ai = 0; ai < 2; ++ai)
#pragma unroll
            for (int m = 0; m < 4; ++m) {
                const int row = u.pm * 256 + ai * 128 + wr * 64 + m * 16 + fr;
#pragma unroll
                for (int bj = 0; bj < 2; ++bj) {
                    const f32x4 g = acc[ai][bj][m][0], up = acc[ai][bj][m][1];
                    f32x4 a;
#pragma unroll
                    for (int e = 0; e < 4; ++e) a[e] = g[e] * __builtin_amdgcn_rcpf(1.f + ex2(-g[e] * LOG2E)) * up[e];
                    *(u32x2*)(ACT + (size_t)row * DFF + u.pn * 128 + bj * 64 + wc * 16 + fq * 4) = pack4(a);
                }
            }
    }
};

#define MFMA32(a, b, c) __builtin_amdgcn_mfma_f32_32x32x16_bf16((a), (b), (c), 0, 0, 0)
DI s16x4 vtr(const LAS unsigned char* p) { return __builtin_bit_cast(s16x4, __builtin_amdgcn_ds_read_tr16_b64_v4i16((LAS v4i16_t*)p)); }

template <bool F32>
DI void load_chunk(f32x4 (&rk)[8], f32x4 (&rv)[8], u32x4 (&bk)[4], u32x4 (&bv)[4], int f0,
                   const void* kb0, const void* kb1, const void* vb0, const void* vb1, int pitch, int L, int c, int rr, int fmax, int lane) {
    if (!F32) {
        const int row0 = c + rr * (f0 + (lane >> 3));
        const bf16_t* kp = (const bf16_t*)kb0 + (size_t)row0 * pitch + 8 * (lane & 7);
        const bf16_t* vp = (const bf16_t*)vb0 + (size_t)row0 * pitch + 8 * (lane & 7);
        const size_t js = (size_t)8 * rr * pitch;
#pragma unroll
        for (int j = 0; j < 4; ++j) { bk[j] = *(const u32x4*)(kp + j * js); bv[j] = *(const u32x4*)(vp + j * js); }
    } else {
#pragma unroll
        for (int j = 0; j < 8; ++j) {
            const int fu = f0 + 4 * j + (lane >> 4); const int fk = fu > fmax ? fmax : fu;
            const int R = c + rr * fk; const bool lo = R < L;
            const size_t off = (size_t)(lo ? R : R - 8) * pitch + 4 * (lane & 15);
            rk[j] = *(const f32x4*)((lo ? (const float*)kb0 : (const float*)kb1) + off);
            rv[j] = *(const f32x4*)((lo ? (const float*)vb0 : (const float*)vb1) + off);
        }
    }
}

template <bool F32>
DI void attn_core(const bf16_t* ZQ, int qrow, int qcol, int qf, int W,
                  const void* kb0, const void* kb1, const void* vb0, const void* vb1, int pitch, int L, int c, int rr, int fmax, int kf0, int nch, int cpy,
                  LAS unsigned char* klds, int lane, float& m_out, float& l_out, f32x16& O0, f32x16& O1) {
    const int r = lane & 31, h = lane >> 5;
    LAS unsigned char* vlds = klds + 4608;
    bf16x8 qfr[4];
    { const bf16_t* qp = ZQ + (size_t)qrow * 1024 + qcol + 8 * h;
#pragma unroll
      for (int st = 0; st < 4; ++st) qfr[st] = *(const bf16x8*)(qp + 16 * st); }
    float m = NEGBIG, l = 0.f;
#pragma unroll
    for (int i = 0; i < 16; ++i) { O0[i] = 0.f; O1[i] = 0.f; }
    const int i16 = lane & 15;
    const LAS unsigned char* vrd = vlds + (4 * h + (i16 >> 2)) * 144 + (16 * ((lane >> 4) & 1) + 4 * (i16 & 3)) * 2;
    const LAS unsigned char* krd = klds + r * 144 + 16 * h;
    const int wof = F32 ? (lane >> 4) * 144 + (lane & 15) * 8 : (lane >> 3) * 144 + (lane & 7) * 16;
    f32x4 rk[8], rv[8]; u32x4 bk[4], bv[4];
    int ch = 0;
    while (ch < nch && kf0 + 32 * ch + 31 < 0) ++ch;
    if (ch < nch) load_chunk<F32>(rk, rv, bk, bv, kf0 + 32 * ch, kb0, kb1, vb0, vb1, pitch, L, c, rr, fmax, lane);
    for (; ch < nch; ++ch) {
        const int f0 = kf0 + 32 * ch;
        if (!F32) {
#pragma unroll
            for (int j = 0; j < 4; ++j) { *(LAS u32x4*)(klds + wof + j * 8 * 144) = bk[j]; *(LAS u32x4*)(vlds + wof + j * 8 * 144) = bv[j]; }
        } else {
#pragma unroll
            for (int j = 0; j < 8; ++j) { *(LAS u32x2*)(klds + wof + j * 4 * 144) = pack4(rk[j]); *(LAS u32x2*)(vlds + wof + j * 4 * 144) = pack4(rv[j]); }
            if (cpy) {
#pragma unroll
                for (int j = 0; j < 8; ++j) {
                    const int fu = f0 + 4 * j + (lane >> 4); const int R = c + rr * fu;
                    const bool w = (fu <= fmax) && (R >= 8) && (R < 2048) && (cpy == 1 || (R >= 1536 && (R & 15) >= 8));
                    if (w) { const size_t off = (size_t)(R - 8) * pitch + 4 * (lane & 15);
                        __builtin_nontemporal_store(rk[j], (f32x4*)((float*)kb1 + off)); __builtin_nontemporal_store(rv[j], (f32x4*)((float*)vb1 + off)); }
                }
            }
        }
        if (ch + 1 < nch) load_chunk<F32>(rk, rv, bk, bv, f0 + 32, kb0, kb1, vb0, vb1, pitch, L, c, rr, fmax, lane);
        bf16x8 kfr[4];
#pragma unroll
        for (int st = 0; st < 4; ++st) kfr[st] = *(const LAS bf16x8*)(krd + 32 * st);
        f32x16 S;
#pragma unroll
        for (int i = 0; i < 16; ++i) S[i] = 0.f;
#pragma unroll
        for (int st = 0; st < 4; ++st) S = MFMA32(kfr[st], qfr[st], S);
        float mx = NEGBIG;
#pragma unroll
        for (int i = 0; i < 16; ++i) {
            const int f = f0 + (i & 3) + 8 * (i >> 2) + 4 * h;
            const int dist = qf - f;
            const bool ok = (f >= 0) && ((unsigned)dist <= (unsigned)W);
            S[i] = ok ? S[i] : NEGBIG;
            mx = fmaxf(mx, S[i]);
        }
        mx = fmaxf(mx, __shfl_xor(mx, 32));
        const float mn = fmaxf(m, mx);
        const float alpha = ex2(m - mn);
        m = mn;
        float rs = 0.f;
#pragma unroll
        for (int i = 0; i < 16; ++i) { S[i] = ex2(S[i] - mn); rs += S[i]; }
        rs += __shfl_xor(rs, 32);
        l = l * alpha + rs;
#pragma unroll
        for (int i = 0; i < 16; ++i) { O0[i] *= alpha; O1[i] *= alpha; }
        u32x4 p0, p1;
        p0.x = pk(S[0], S[1]); p0.y = pk(S[2], S[3]); p0.z = pk(S[4], S[5]); p0.w = pk(S[6], S[7]);
        p1.x = pk(S[8], S[9]); p1.y = pk(S[10], S[11]); p1.z = pk(S[12], S[13]); p1.w = pk(S[14], S[15]);
        const bf16x8 pf0 = __builtin_bit_cast(bf16x8, p0), pf1 = __builtin_bit_cast(bf16x8, p1);
        bf16x8 vf[2][2];
#pragma unroll
        for (int dt = 0; dt < 2; ++dt)
#pragma unroll
            for (int s = 0; s < 2; ++s) {
                const s16x4 lo = vtr(vrd + (16 * s) * 144 + 64 * dt), hi = vtr(vrd + (16 * s + 8) * 144 + 64 * dt);
                vf[dt][s] = __builtin_shufflevector(lo, hi, 0, 1, 2, 3, 4, 5, 6, 7);
            }
        O0 = MFMA32(vf[0][0], pf0, O0); O0 = MFMA32(vf[0][1], pf1, O0);
        O1 = MFMA32(vf[1][0], pf0, O1); O1 = MFMA32(vf[1][1], pf1, O1);
    }
    m_out = m; l_out = l;
}

#define XB_TMO      128
#define XB_XCNT(j)  (256  + 64 * (j))
#define XB_XSUB(j)  (1280 + 64 * (j))
#define XB_XGEN(j)  (2304 + 64 * (j))
#define XB_TOP      3328
#define XB_TOPGEN   3392
#define XCD_BAR_WORDS 3456
#define XB_SPIN_CAP (1u << 18)

__device__ __forceinline__ unsigned xb_ld(unsigned* p)              { return __hip_atomic_load(p, __ATOMIC_RELAXED, __HIP_MEMORY_SCOPE_AGENT); }
__device__ __forceinline__ unsigned xb_add(unsigned* p, unsigned v) { return __hip_atomic_fetch_add(p, v, __ATOMIC_RELAXED, __HIP_MEMORY_SCOPE_AGENT); }
__device__ __forceinline__ unsigned xb_xcc_id() { return (unsigned)__builtin_amdgcn_s_getreg((3 << 11) | 20) & 0xFu; }
#define XB_SPIN(cond, bar) do { unsigned _sp = 0; while (cond) { __builtin_amdgcn_s_sleep(1); \
    if ((++_sp & 255u) == 0u) { if (xb_ld(&(bar)[XB_TMO])) break; if (_sp > XB_SPIN_CAP) { atomicAdd(&(bar)[XB_TMO], 1u); break; } } } } while (0)

struct XcdBarrier {
    unsigned* bar; unsigned x;
    volatile LAS unsigned* st;
};

__device__ __forceinline__ XcdBarrier xcd_barrier_post(unsigned* bar, volatile LAS unsigned* st) {
    XcdBarrier b; b.bar = bar; b.x = xb_xcc_id(); b.st = st;
    if (threadIdx.x == 0) (void)xb_add(&bar[XB_XCNT(b.x)], 1u);
    return b;
}
__device__ __forceinline__ void xcd_barrier_complete(unsigned* bar, unsigned x, unsigned& nloc, unsigned& nx) {
    const unsigned G = gridDim.x * gridDim.y * gridDim.z;
    unsigned sum, cnt, mine, sp = 0u;
    for (;;) {
        sum = 0u; cnt = 0u; mine = 0u;
#pragma unroll
        for (unsigned j = 0; j < 16; ++j) { const unsigned c = xb_ld(&bar[XB_XCNT(j)]); sum += c; cnt += (c > 0u) ? 1u : 0u; mine = (j == x) ? c : mine; }
        if (sum == G) break;
        __builtin_amdgcn_s_sleep(1);
        if ((++sp & 255u) == 0u) { if (xb_ld(&bar[XB_TMO])) break; if (sp > XB_SPIN_CAP) { atomicAdd(&bar[XB_TMO], 1u); break; } }
    }
    nloc = mine > 0u ? mine : 1u; nx = cnt > 0u ? cnt : 1u;
}

__device__ __forceinline__ void xcd_barrier(const XcdBarrier& b) {
    asm volatile("s_waitcnt vmcnt(0)" ::: "memory");
    __syncthreads();
    if (threadIdx.x == 0) {
        unsigned* bar = b.bar;
        __builtin_amdgcn_s_waitcnt(0);
        unsigned nloc = b.st[0], nx = b.st[1];
        if (nloc == 0u) { xcd_barrier_complete(bar, b.x, nloc, nx); b.st[0] = nloc; b.st[1] = nx; }
        const unsigned old = xb_add(&bar[XB_XSUB(b.x)], 1u);
        const unsigned gen = old / nloc;
        if (old + 1u == (gen + 1u) * nloc) {
            __builtin_amdgcn_fence(__ATOMIC_RELEASE, "agent");
            asm volatile("s_waitcnt vmcnt(0)" ::: "memory");
            const unsigned og = xb_add(&bar[XB_TOP], 1u);
            const unsigned tg = og / nx;
            if (og + 1u == (tg + 1u) * nx) xb_add(&bar[XB_TOPGEN], 1u);
            else XB_SPIN(xb_ld(&bar[XB_TOPGEN]) == tg, bar);
            __builtin_amdgcn_fence(__ATOMIC_ACQUIRE, "agent");
            xb_add(&bar[XB_XGEN(b.x)], 1u);
            asm volatile("s_waitcnt vmcnt(0)" ::: "memory");
        } else {
            XB_SPIN(xb_ld(&bar[XB_XGEN(b.x)]) == gen, bar);
            __builtin_amdgcn_fence(__ATOMIC_ACQUIRE, "agent");
            asm volatile("s_waitcnt vmcnt(0)" ::: "memory");
        }
    }
    __syncthreads();
}

struct BgCopy { const float* src; float* dst; };
DI void bg_copy_all(const BgCopy& B, int wave, int) {
    const int lane = (int)__builtin_amdgcn_mbcnt_hi(~0u, __builtin_amdgcn_mbcnt_lo(~0u, 0u));
    const f32x4* sp = (const f32x4*)B.src + lane + (size_t)wave * 768; f32x4* dp = (f32x4*)B.dst + lane + (size_t)wave * 768;
    const int nk = (255 - wave + 7) >> 3;
    for (int q = 0; q < 8; ++q) {
        f32x4 t[48];
#pragma unroll
        for (int cc = 0; cc < 4; ++cc) { const int j = 4 * q + cc; const f32x4* s_ = sp + (size_t)(j < nk ? j : nk - 1) * 6144;
#pragma unroll
            for (int i = 0; i < 12; ++i) t[12 * cc + i] = __builtin_nontemporal_load(s_ + 64 * i); }
#pragma unroll
        for (int cc = 0; cc < 4; ++cc) { const int j = 4 * q + cc; if (j < nk) { f32x4* d_ = dp + (size_t)j * 6144;
#pragma unroll
            for (int i = 0; i < 12; ++i) __builtin_nontemporal_store(t[12 * cc + i], d_ + 64 * i); } }
    }
}
template <class Base> struct SchedBg {
    Base base; BgCopy bg; int wave, lane, my_round; mutable int idx;
    DI bool next(int i, Unit& u) const { return base.next(i, u); }
    DI void a_ready(const Unit&) const {}
    DI void done(const Unit&) const { if (idx++ == my_round) bg_copy_all(bg, wave, lane); }
};

struct Params { const float* in[20]; float* out; unsigned char* ws; };
DI void norm_row(const float* xp, const float* xs, const float* mp, const float* gpre, bf16_t* AALL, int row, int lane) {
    const float* xr = row < NP ? xp + (size_t)row * 1024 : (row < NT ? xs + (size_t)(row - NP) * 1024 : mp + (size_t)(row - NT) * 1024);
    f32x4 v[4]; float s = 0.f;
#pragma unroll
    for (int j = 0; j < 4; ++j) { v[j] = ((const f32x4*)xr)[lane + 64 * j]; s += (v[j][0] * v[j][0] + v[j][1] * v[j][1]) + (v[j][2] * v[j][2] + v[j][3] * v[j][3]); }
    if (row < NT) {
        s = wave_sum(s); const float rstd = 1.0f / sqrtf(s * (1.f / 1024.f) + EPS);
#pragma unroll
        for (int j = 0; j < 4; ++j) { const f32x4 g = ((const f32x4*)gpre)[lane + 64 * j]; v[j] = v[j] * rstd * g; }
    }
#pragma unroll
    for (int j = 0; j < 4; ++j) *(u32x2*)(AALL + (size_t)row * 1024 + 4 * lane + 256 * j) = pack4(v[j]);
}
struct SchedX {
    int c;
    DI bool next(int i, Unit& u) const {
        if (i != 0) return false;
        if (c < 32) { u.pm = 64 + (c >> 3); u.pn = c & 7; } else { const int e = c - 32; u.pm = 68 + (e >> 1); u.pn = 8 + (e & 1); }
        u.ks = 0; u.kt = 0; return true;
    }
    DI void a_ready(const Unit&) const {}
    DI void done(const Unit&) const {}
};


constexpr int U_SB2 = 128 * 6 * 8, U_SB1 = 128 * 6 * 4, U_SB0 = 128 * 6, U_SA = 128 * 2, U_SX = 128 * 4;
constexpr int U_PB = 4 * 6 * 3 * 128, U_PA = 4 * 6 * 128, U_PX = 4 * 4 * 128;
constexpr int U_S_END = U_SB2 + U_SB1 + U_SB0 + U_SA + U_SX;
constexpr int U_TOTAL = U_S_END + U_PB + U_PA + U_PX;

DI void attn_unit(const Params& p, int uid, int lane, LAS unsigned char* vlds) {
    unsigned char* ws = p.ws;
    const bf16_t* ZQ = (const bf16_t*)(ws + WS_ZQ);
    bf16_t* CAT = (bf16_t*)(ws + WS_CAT);
    bf16_t* BPO = (bf16_t*)(ws + WS_BPO);
    f32x2_t* BPM = (f32x2_t*)(ws + WS_BPM);
    const int r = lane & 31, h = lane >> 5;
    bool qvalid = true; int qrow = 0, qcol = 0, qf = 0, head = 0;
    int mode = 0  , pi = 0, W = 128, pitch = 0, L = 0, c = 0, rr = 1, fmax = 0, kf0 = 0, nch = 5;
    const void *kb0 = nullptr, *kb1 = nullptr, *vb0 = nullptr, *vb1 = nullptr;
    int cpy = 0;
    float m, l; f32x16 O0, O1;
    if (uid < U_S_END) {
        int u;
        { const int n_ = uid / 84, lo_ = uid - n_ * 84;
          u = lo_ < 48 ? n_ * 48 + lo_ : (lo_ < 72 ? U_SB2 + n_ * 24 + (lo_ - 48) : (lo_ < 78 ? U_SB2 + U_SB1 + n_ * 6 + (lo_ - 72) : (lo_ < 80 ? U_SB2 + U_SB1 + U_SB0 + n_ * 2 + (lo_ - 78) : U_SB2 + U_SB1 + U_SB0 + U_SA + n_ * 4 + (lo_ - 80)))); }
        if (u < U_SB2 + U_SB1 + U_SB0) {
            int n, hd, i0, nq, istep;
            if (u < U_SB2) { pi = 2; rr = 16; n = u / 48; hd = u % 6; c = (u - n * 48) / 6;     nq = 1; i0 = c; istep = 0; qf = 128; kf0 = 0; fmax = (2055 - c) >> 4; }
            else if (u < U_SB2 + U_SB1) { u -= U_SB2; pi = 1; rr = 4; n = u / 24; hd = u % 6; c = (u - n * 24) / 6; nq = 2; i0 = c; istep = 4; qf = 512 + r; kf0 = 384; fmax = (2055 - c) >> 2; }
            else { u -= U_SB2 + U_SB1; pi = 0; rr = 1; c = 0; hd = u % 6; n = u / 6; nq = 8; i0 = 0; istep = 1; qf = 2048 + r; kf0 = 1920; fmax = 2055; }
            qvalid = r < nq; const int rq = qvalid ? r : 0;
            if (!qvalid) qf = (pi == 2) ? 128 : (pi == 1 ? 512 : 2048);
            qrow = NP + n * 8 + i0 + istep * rq; head = hd; qcol = 384 + hd * 64; mode = 2;
            pitch = 384; L = 2048;
            kb0 = p.in[4] + (size_t)n * 2048 * 384 + hd * 64; vb0 = p.in[5] + (size_t)n * 2048 * 384 + hd * 64;
            kb1 = p.out + O_SDK + (size_t)n * 2048 * 384 + hd * 64; vb1 = p.out + O_SDV + (size_t)n * 2048 * 384 + hd * 64;
            cpy = pi == 2 ? 1 : (pi == 1 ? 2 : 0);
        } else if (u < U_SB2 + U_SB1 + U_SB0 + U_SA) {
            u -= U_SB2 + U_SB1 + U_SB0;
            const int kvh = u & 1, n = u >> 1;
            qvalid = r < 24; const int rq = qvalid ? r : 0;
            head = kvh * 3 + (rq >> 3); qrow = NP + n * 8 + (rq & 7); qcol = head * 64; qf = 128 + (rq & 7); mode = 1;
            pitch = 128; L = 128; kf0 = 0; fmax = 135;
            kb0 = p.in[2] + (size_t)n * 128 * 128 + kvh * 64; vb0 = p.in[3] + (size_t)n * 128 * 128 + kvh * 64;
            kb1 = p.out + O_SSK + (size_t)n * 128 * 128 + kvh * 64; vb1 = p.out + O_SSV + (size_t)n * 128 * 128 + kvh * 64;
        } else {
            u -= U_SB2 + U_SB1 + U_SB0 + U_SA;
            const int hd = u & 3, n = u >> 2;
            qvalid = r < 8; const int rq = qvalid ? r : 0;
            head = hd; qrow = NP + n * 8 + rq; qcol = 768 + hd * 64; qf = 1 << 20; W = 1 << 30; mode = 0;
            pitch = 256; L = 1 << 20; kf0 = 0; fmax = 255; nch = 8;
            kb0 = p.in[6] + (size_t)n * 256 * 256 + hd * 64; vb0 = p.in[7] + (size_t)n * 256 * 256 + hd * 64; kb1 = kb0; vb1 = vb0;
        }
        attn_core<true>(ZQ, qrow, qcol, qf, W, kb0, kb1, vb0, vb1, pitch, L, c, rr, fmax, kf0, nch, cpy, vlds, lane, m, l, O0, O1);
    } else {
        int u = uid - U_S_END;
        if (u < U_PB) {
            const int idx = u & 127; int t = u >> 7; pi = t % 3; t /= 3; const int hd = t % 6, b = t / 6;
            rr = pi == 0 ? 1 : (pi == 1 ? 4 : 16);
            const int tiles = 128 / rr; c = idx / tiles; const int ft = idx % tiles;
            qf = 32 * ft + r; qrow = b * 4096 + c + rr * qf; head = hd; qcol = 384 + hd * 64; mode = 2;
            pitch = 384; kf0 = 32 * ft - 128; fmax = 4096 / rr - 1;
            kb0 = (const bf16_t*)(ws + WS_KB) + (size_t)b * 4096 * 384 + hd * 64; vb0 = (const bf16_t*)(ws + WS_VB) + (size_t)b * 4096 * 384 + hd * 64;
        } else if (u < U_PB + U_PA) {
            u -= U_PB;
            const int tile = u & 127; const int t = u >> 7; const int hd = t % 6, b = t / 6, kvh = hd / 3;
            qf = 32 * tile + r; qrow = b * 4096 + qf; head = hd; qcol = hd * 64; mode = 1;
            pitch = 128; kf0 = 32 * tile - 128; fmax = 4095;
            kb0 = (const bf16_t*)(ws + WS_KA) + (size_t)b * 4096 * 128 + kvh * 64; vb0 = (const bf16_t*)(ws + WS_VA) + (size_t)b * 4096 * 128 + kvh * 64;
        } else {
            u -= U_PB + U_PA;
            const int tile = u & 127; const int t = u >> 7; const int hd = t & 3, b = t >> 2;
            qrow = b * 4096 + 32 * tile + r; head = hd; qcol = 768 + hd * 64; qf = 1 << 20; W = 1 << 30; mode = 0;
            pitch = 256; kf0 = 0; fmax = 255; nch = 8;
            kb0 = (const bf16_t*)(ws + WS_MK) + (size_t)b * 256 * 256 + hd * 64; vb0 = (const bf16_t*)(ws + WS_MV) + (size_t)b * 256 * 256 + hd * 64;
        }
        attn_core<false>(ZQ, qrow, qcol, qf, W, kb0, kb0, vb0, vb0, pitch, 1 << 30, c, rr, fmax, kf0, nch, 0, vlds, lane, m, l, O0, O1);
    }
    float scale;
    if (mode == 1) { const float s2 = p.in[11][head] * LOG2E; const float mm = fmaxf(m, s2); const float a = ex2(m - mm); scale = a / (l * a + ex2(s2 - mm)); }
    else scale = 1.f / l;
    if (qvalid) {
        bf16_t* dst = (mode == 2) ? BPO + ((size_t)pi * NT + qrow) * 384 + head * 64 : CAT + (size_t)qrow * 1024 + qcol;
#pragma unroll
        for (int i4 = 0; i4 < 4; ++i4) {
            f32x4 a = {O0[4 * i4] * scale, O0[4 * i4 + 1] * scale, O0[4 * i4 + 2] * scale, O0[4 * i4 + 3] * scale};
            f32x4 b = {O1[4 * i4] * scale, O1[4 * i4 + 1] * scale, O1[4 * i4 + 2] * scale, O1[4 * i4 + 3] * scale};
            *(u32x2*)(dst + 8 * i4 + 4 * h) = pack4(a);
            *(u32x2*)(dst + 32 + 8 * i4 + 4 * h) = pack4(b);
        }
        if (mode == 2 && h == 0) { f32x2_t ml = {m, l}; BPM[((size_t)pi * NT + qrow) * 6 + head] = ml; }
    }
}

__global__ void __launch_bounds__(512, 2) fwd_kernel(Params p) {
    extern __shared__ __attribute__((aligned(16))) unsigned char lds_raw[];
    LAS unsigned char* lds = (LAS unsigned char*)lds_raw;
    cg::grid_group grid = cg::this_grid();
    const int tid = threadIdx.x, lane = tid & 63, wave = __builtin_amdgcn_readfirstlane(tid >> 6);
    const int G = gridDim.x, gw = blockIdx.x * 8 + wave, NGW = G * 8, gt = blockIdx.x * 512 + tid, NGT = G * 512;
    unsigned char* ws = p.ws;
    bf16_t* WIN = (bf16_t*)(ws + WS_WIN); bf16_t* WO = (bf16_t*)(ws + WS_WO); bf16_t* WGU = (bf16_t*)(ws + WS_WGU); bf16_t* WD = (bf16_t*)(ws + WS_WD);
    bf16_t* AALL = (bf16_t*)(ws + WS_AALL); bf16_t* CAT = (bf16_t*)(ws + WS_CAT); bf16_t* TB = (bf16_t*)(ws + WS_T); bf16_t* ACT = (bf16_t*)(ws + WS_ACT);
    float* SS = (float*)(ws + WS_SS); float* PART = (float*)(ws + WS_PART); f32x2_t* ROT = (f32x2_t*)(ws + WS_ROT);
    float* Y = p.out + O_Y; bf16_t* X1B = (bf16_t*)(ws + WS_BPO);
    if (tid < 64) ((LAS unsigned*)(lds + 131072))[tid] = 0u;
    __syncthreads();
    const XcdBarrier xbar = xcd_barrier_post((unsigned*)(ws + WS_CTL) + 1024, (volatile LAS unsigned*)(lds + 131072));

    {
        LAS float* scr = (LAS float*)(lds + wave * 16384);
        constexpr int I_IN = 16 * 64, I_MEM = 16 * 16;
        for (int it = gw; it < I_IN + I_MEM; it += NGW) {
            if (it < I_IN) tr_item<1>(p.in[10], nullptr, 1024, 2048, 2048, WIN, 0, scr, it, lane);
            else tr_item<1>(p.in[12], nullptr, 1024, 512, 512, WIN, 2048, scr, it - I_IN, lane);
        }
        for (int row = NP + gw; row < NT + 1024; row += NGW) norm_row(p.in[0], p.in[1], p.in[8], p.in[9], AALL, row, lane);
        for (int idx = gt; idx < 4104 * 32; idx += NGT) {
            const int pp = idx >> 5, i = idx & 31; const int pos = pp < 4096 ? pp : 16384 + (pp - 4096);
            double rev = (double)pos * INVF[i] * 0.15915494309189535; rev -= __builtin_rint(rev);
            const float fr = (float)rev;
            f32x2_t cs = {__builtin_amdgcn_cosf(fr), __builtin_amdgcn_sinf(fr)};
            ROT[idx] = cs;
        }
    }
    if (p.ws == nullptr) grid.sync();
    xcd_barrier(xbar);

    constexpr int NXB = 40;
    if ((int)blockIdx.x < NXB) {
        Gemm g{AALL, WIN, NT + 1024, 2560, 1024};
        SchedX S; S.c = (int)blockIdx.x;
        EpiQKV E{ws, p.out, (const f32x4*)ROT};
        gemm_phase<EpiQKV, SchedX, true, true>(lds, g, S, E);
    } else {
        LAS float* scr = (LAS float*)(lds + wave * 16384);
        const int gw2 = ((int)blockIdx.x - NXB) * 8 + wave, NGW2 = (G - NXB) * 8, gt2 = ((int)blockIdx.x - NXB) * 512 + tid, NGT2 = (G - NXB) * 512;
        constexpr int I_O = 16 * 32, I_GU = 16 * 176, I_D = 44 * 32;
        for (int it = gw2; it < I_O + I_GU + I_D; it += NGW2) {
            int r = it;
            if (r < I_O) { tr_item<0>(p.in[13], nullptr, 1024, 1024, 1024, WO, 0, scr, r, lane); continue; } r -= I_O;
            if (r < I_GU) { tr_item<2>(p.in[16], p.in[17], 1024, 5632, 2816, WGU, 0, scr, r, lane); continue; } r -= I_GU;
            tr_item<0>(p.in[18], nullptr, 2816, 1024, 1024, WD, 0, scr, r, lane);
        }
        for (int row = gw2; row < NP; row += 2 * NGW2) {
            const int row1 = row + NGW2; const bool has1 = row1 < NP;
            const f32x4* x0 = (const f32x4*)(p.in[0] + (size_t)row * 1024) + lane; const f32x4* x1p = (const f32x4*)(p.in[0] + (size_t)(has1 ? row1 : row) * 1024) + lane;
            f32x4 a[4], b[4], g[4]; float sa = 0.f, sb = 0.f;
#pragma unroll
            for (int j = 0; j < 4; ++j) { a[j] = x0[64 * j]; b[j] = x1p[64 * j]; g[j] = ((const f32x4*)p.in[9])[lane + 64 * j]; }
#pragma unroll
            for (int j = 0; j < 4; ++j) { sa += (a[j][0] * a[j][0] + a[j][1] * a[j][1]) + (a[j][2] * a[j][2] + a[j][3] * a[j][3]); sb += (b[j][0] * b[j][0] + b[j][1] * b[j][1]) + (b[j][2] * b[j][2] + b[j][3] * b[j][3]); }
            sa = wave_sum(sa); sb = wave_sum(sb);
            const float ra = 1.0f / sqrtf(sa * (1.f / 1024.f) + EPS), rb = 1.0f / sqrtf(sb * (1.f / 1024.f) + EPS);
#pragma unroll
            for (int j = 0; j < 4; ++j) *(u32x2*)(AALL + (size_t)row * 1024 + 4 * lane + 256 * j) = pack4(a[j] * ra * g[j]);
            if (has1) {
#pragma unroll
                for (int j = 0; j < 4; ++j) *(u32x2*)(AALL + (size_t)row1 * 1024 + 4 * lane + 256 * j) = pack4(b[j] * rb * g[j]);
            }
        }
        copy_shift(p.in[2], p.out + O_SSK, 120 * 128 / 4, 8 * 128, 128 * 128, gt2, NGT2);
        copy_shift(p.in[3], p.out + O_SSV, 120 * 128 / 4, 8 * 128, 128 * 128, gt2, NGT2);
    }
    xcd_barrier(xbar);

    {
        Gemm g{AALL, WIN, NT + 1024, 2560, 1024};
        StaticOrder S; S.init(NP, 2048, G, (int)blockIdx.x);
        EpiQKV E{ws, p.out, (const f32x4*)ROT};
        gemm_phase<EpiQKV, StaticOrder, true, true>(lds, g, S, E);
    }
    xcd_barrier(xbar);

    {
        LAS unsigned char* vlds = lds + wave * 9216;
        constexpr int NCU = 2 * 128 * 24;
        constexpr int NM = U_S_END + NCU, NC = U_TOTAL - U_S_END;
        for (int k = 0; k * NGW < (NM > NC ? NM : NC); ++k) {
            const int ui = gw + k * NGW;
            for (int half = 0; half < 2; ++half) {
                const bool doM = ((half ^ wave) & 1) == 0;
                int uid = -1, cu = -1;
                if (doM) {
                    if (ui < U_S_END) {
                        uid = ui;
                        if (G == 256) {
                            const int x_ = (int)blockIdx.x & 7, ux_ = ((int)blockIdx.x >> 3) * 8 + wave + 256 * k;
                            uid = ux_ < 1344 ? ((ux_ / 84) * 8 + x_) * 84 + ux_ % 84 : -1;
                        }
                    } else if (ui < NM) cu = ui - U_S_END;
                } else if (ui < NC) {
                    uid = U_S_END + ui;
                    if (G == 256) {
                        const int x_ = (int)blockIdx.x & 7, ux_ = ((int)blockIdx.x >> 3) * 8 + wave + 256 * k;
                        const int j_ = ux_ >> 7;
                        const int grp_ = j_ < 9 ? (x_ * 3 + j_ / 3) * 3 + j_ % 3 : (j_ < 12 ? 72 + (x_ >> 1) * 6 + (x_ & 1) * 3 + (j_ - 9) : 96 + x_ * 2 + (j_ - 12));
                        uid = U_S_END + grp_ * 128 + (ux_ & 127);
                    }
                }
                if (uid >= 0) attn_unit(p, uid, lane, vlds);
                else if (cu >= 0) {
                    const int tensor = cu & 1, n = (cu >> 1) & 127, g4 = cu >> 8;
                    const float* src = p.in[4 + tensor] + (size_t)n * 2048 * 384; float* dst = p.out + (tensor ? O_SDV : O_SDK) + (size_t)n * 2048 * 384;
                    for (int jh = 0; jh < 4; jh += 2) {
                        f32x4 t[2][12];
#pragma unroll
                        for (int j = 0; j < 2; ++j) { const f32x4* sp = (const f32x4*)(src + (size_t)(16 * (4 * g4 + jh + j) + 8) * 384) + lane;
#pragma unroll
                            for (int i = 0; i < 12; ++i) t[j][i] = __builtin_nontemporal_load(sp + 64 * i); }
#pragma unroll
                        for (int j = 0; j < 2; ++j) { f32x4* dp = (f32x4*)(dst + (size_t)(16 * (4 * g4 + jh + j)) * 384) + lane;
#pragma unroll
                            for (int i = 0; i < 12; ++i) __builtin_nontemporal_store(t[j][i], dp + 64 * i); }
                    }
                }
            }
        }
    }
    xcd_barrier(xbar);

    {
        const bf16_t* BPO = (const bf16_t*)(ws + WS_BPO); const f32x2_t* BPM = (const f32x2_t*)(ws + WS_BPM);
        for (int idx = gt; idx < NT * 48; idx += NGT) {
            const int ch = idx & 7, t = idx >> 3, head = t % 6, row = t / 6;
            f32x2_t ml[3];
#pragma unroll
            for (int i = 0; i < 3; ++i) ml[i] = BPM[((size_t)i * NT + row) * 6 + head];
            const float M = fmaxf(ml[0][0], fmaxf(ml[1][0], ml[2][0]));
            float w[3], den = 0.f;
#pragma unroll
            for (int i = 0; i < 3; ++i) { w[i] = ml[i][1] * ex2(ml[i][0] - M); den += w[i]; }
            const float inv = 1.f / den;
            f32x4 a = {0.f, 0.f, 0.f, 0.f}, b = {0.f, 0.f, 0.f, 0.f};
#pragma unroll
            for (int i = 0; i < 3; ++i) {
                const u32x4 v = *(const u32x4*)(BPO + ((size_t)i * NT + row) * 384 + head * 64 + 8 * ch);
                u32x2 lo = {v.x, v.y}, hi = {v.z, v.w};
                a += unpack4(lo) * (w[i] * inv); b += unpack4(hi) * (w[i] * inv);
            }
            *(bf16x8*)(CAT + (size_t)row * 1024 + 384 + head * 64 + 8 * ch) = pack8(a, b);
        }
    }
    xcd_barrier(xbar);

    {
        Gemm g{CAT, WO, NT, 1024, 1024};
        SchedSK S; S.init(G, (int)blockIdx.x, 1024);
        EpiT E{TB, SS, PART};
        gemm_phase<EpiT, SchedSK, true, true>(lds, g, S, E);
    }
    xcd_barrier(xbar);

    int p4_first = gw;
    if (NGW == 2048) {
        const int lane = fresh_lane();
        f32x4 g1[4], g2[4];
#pragma unroll
        for (int j = 0; j < 4; ++j) { g1[j] = ((const f32x4*)p.in[14])[lane + 64 * j]; g2[j] = ((const f32x4*)p.in[15])[lane + 64 * j]; }
        for (int k0 = 0; k0 < 8; k0 += 2) {
            u32x2 tb[2][4]; f32x4 xv[2][4]; float ssq[2];
#pragma unroll
            for (int i = 0; i < 2; ++i) {
                const int row = gw + (k0 + i) * 2048;
#pragma unroll
                for (int j = 0; j < 4; ++j) { tb[i][j] = *(const u32x2*)(TB + (size_t)row * 1024 + 4 * lane + 256 * j); xv[i][j] = ((const f32x4*)(p.in[0] + (size_t)row * 1024))[lane + 64 * j]; }
                float a_ = 0.f;
#pragma unroll
                for (int s_ = 0; s_ < 16; ++s_) a_ += SS[(size_t)s_ * NT + row];
                ssq[i] = a_;
            }
            float s2[2];
#pragma unroll
            for (int i = 0; i < 2; ++i) {
                const int row = gw + (k0 + i) * 2048;
                const float rstd = 1.0f / sqrtf(ssq[i] * (1.f / 1024.f) + EPS);
                float q_ = 0.f;
#pragma unroll
                for (int j = 0; j < 4; ++j) {
                    xv[i][j] = xv[i][j] + unpack4(tb[i][j]) * rstd * g1[j];
                    *(u32x2*)(X1B + (size_t)row * 1024 + 4 * lane + 256 * j) = pack4(xv[i][j]);
                    q_ += (xv[i][j][0] * xv[i][j][0] + xv[i][j][1] * xv[i][j][1]) + (xv[i][j][2] * xv[i][j][2] + xv[i][j][3] * xv[i][j][3]);
                }
                s2[i] = q_;
            }
            s2[0] = wave_sum(s2[0]); s2[1] = wave_sum(s2[1]);
#pragma unroll
            for (int i = 0; i < 2; ++i) {
                const int row = gw + (k0 + i) * 2048;
                const float r2 = 1.0f / sqrtf(s2[i] * (1.f / 1024.f) + EPS);
#pragma unroll
                for (int j = 0; j < 4; ++j) *(u32x2*)(AALL + (size_t)row * 1024 + 4 * lane + 256 * j) = pack4(xv[i][j] * r2 * g2[j]);
            }
        }
        p4_first = gw + 8 * 2048;
    }
    for (int row = p4_first; row < NT; row += NGW) {
        const int lane = fresh_lane();
        float ss = 0.f; f32x4 tv[4];
        if (row < NP) {
#pragma unroll
            for (int s = 0; s < 16; ++s) ss += SS[(size_t)s * NT + row];
#pragma unroll
            for (int j = 0; j < 4; ++j) tv[j] = unpack4(*(const u32x2*)(TB + (size_t)row * 1024 + 4 * lane + 256 * j));
        } else {
#pragma unroll
            for (int j = 0; j < 4; ++j) tv[j] = (f32x4){0.f, 0.f, 0.f, 0.f};
            for (int s = 0; s < 4; ++s)
#pragma unroll
                for (int j = 0; j < 4; ++j) tv[j] += ((const f32x4*)(PART + ((size_t)s * 1024 + (row - NP)) * 1024))[lane + 64 * j];
#pragma unroll
            for (int j = 0; j < 4; ++j) ss += (tv[j][0] * tv[j][0] + tv[j][1] * tv[j][1]) + (tv[j][2] * tv[j][2] + tv[j][3] * tv[j][3]);
            ss = wave_sum(ss);
        }
        const float rstd = 1.0f / sqrtf(ss * (1.f / 1024.f) + EPS);
        const float* xr = row < NP ? p.in[0] + (size_t)row * 1024 : p.in[1] + (size_t)(row - NP) * 1024;
        f32x4 x1[4]; float s2 = 0.f;
#pragma unroll
        for (int j = 0; j < 4; ++j) {
            const f32x4 t = tv[j];
            const f32x4 g = ((const f32x4*)p.in[14])[lane + 64 * j];
            x1[j] = ((const f32x4*)xr)[lane + 64 * j] + t * rstd * g;
            *(u32x2*)(X1B + (size_t)row * 1024 + 4 * lane + 256 * j) = pack4(x1[j]);
            s2 += (x1[j][0] * x1[j][0] + x1[j][1] * x1[j][1]) + (x1[j][2] * x1[j][2] + x1[j][3] * x1[j][3]);
        }
        s2 = wave_sum(s2); const float r2 = 1.0f / sqrtf(s2 * (1.f / 1024.f) + EPS);
#pragma unroll
        for (int j = 0; j < 4; ++j) { const f32x4 g = ((const f32x4*)p.in[15])[lane + 64 * j]; *(u32x2*)(AALL + (size_t)row * 1024 + 4 * lane + 256 * j) = pack4(x1[j] * r2 * g); }
    }
    xcd_barrier(xbar);

    {
        Gemm g{AALL, WGU, NT, 5632, 1024};
        StaticOrder S; S.init(NT, 5632, G, (int)blockIdx.x);
        EpiAct E{ACT};
        gemm_phase<EpiAct, StaticOrder, true, true>(lds, g, S, E);
    }
    xcd_barrier(xbar);

    {
        Gemm g{ACT, WD, NT, 1024, DFF};
        SchedSK S; S.init(G, (int)blockIdx.x, DFF);
        EpiT E{TB, SS, PART};
        gemm_phase<EpiT, SchedSK, true, true>(lds, g, S, E);
    }
    xcd_barrier(xbar);

    int p7_first = gw;
    if (NGW == 2048) {
        const int lane = fresh_lane();
        f32x4 gq[4];
#pragma unroll
        for (int j = 0; j < 4; ++j) gq[j] = ((const f32x4*)p.in[19])[lane + 64 * j];
        for (int k0 = 0; k0 < 8; k0 += 4) {
            u32x2 tb[4][4], xb[4][4]; float ssq[4];
#pragma unroll
            for (int i = 0; i < 4; ++i) {
                const int row = gw + (k0 + i) * 2048;
#pragma unroll
                for (int j = 0; j < 4; ++j) { tb[i][j] = *(const u32x2*)(TB + (size_t)row * 1024 + 4 * lane + 256 * j); xb[i][j] = *(const u32x2*)(X1B + (size_t)row * 1024 + 4 * lane + 256 * j); }
                float a_ = 0.f;
#pragma unroll
                for (int s_ = 0; s_ < 16; ++s_) a_ += SS[(size_t)s_ * NT + row];
                ssq[i] = a_;
            }
#pragma unroll
            for (int i = 0; i < 4; ++i) {
                const int row = gw + (k0 + i) * 2048;
                const float rstd = 1.0f / sqrtf(ssq[i] * (1.f / 1024.f) + EPS);
#pragma unroll
                for (int j = 0; j < 4; ++j) ((f32x4*)(Y + (size_t)row * 1024))[lane + 64 * j] = unpack4(xb[i][j]) + unpack4(tb[i][j]) * rstd * gq[j];
            }
        }
        p7_first = gw + 8 * 2048;
    }
    for (int row = p7_first; row < NT; row += NGW) {
        const int lane = fresh_lane();
        float ss = 0.f; f32x4 tv[4];
        if (row < NP) {
#pragma unroll
            for (int s = 0; s < 16; ++s) ss += SS[(size_t)s * NT + row];
#pragma unroll
            for (int j = 0; j < 4; ++j) tv[j] = unpack4(*(const u32x2*)(TB + (size_t)row * 1024 + 4 * lane + 256 * j));
        } else {
#pragma unroll
            for (int j = 0; j < 4; ++j) tv[j] = (f32x4){0.f, 0.f, 0.f, 0.f};
            for (int s = 0; s < 11; ++s)
#pragma unroll
                for (int j = 0; j < 4; ++j) tv[j] += ((const f32x4*)(PART + ((size_t)s * 1024 + (row - NP)) * 1024))[lane + 64 * j];
#pragma unroll
            for (int j = 0; j < 4; ++j) ss += (tv[j][0] * tv[j][0] + tv[j][1] * tv[j][1]) + (tv[j][2] * tv[j][2] + tv[j][3] * tv[j][3]);
            ss = wave_sum(ss);
        }
        const float rstd = 1.0f / sqrtf(ss * (1.f / 1024.f) + EPS);
#pragma unroll
        for (int j = 0; j < 4; ++j) {
            const f32x4 t = tv[j];
            const f32x4 g = ((const f32x4*)p.in[19])[lane + 64 * j];
            const f32x4 x1v = unpack4(*(const u32x2*)(X1B + (size_t)row * 1024 + 4 * lane + 256 * j));
            ((f32x4*)(Y + (size_t)row * 1024))[lane + 64 * j] = x1v + t * rstd * g;
        }
    }
}

extern "C" void kernel_launch(void* const* d_in, const int* in_sizes, int n_in, void* d_out, int out_size, void* d_ws, size_t ws_size, hipStream_t stream) {
    static int grid_blocks = 0;
    if (!grid_blocks) {
        int dev = 0, cus = 0, per_cu = 0;
        (void)hipGetDevice(&dev);
        (void)hipDeviceGetAttribute(&cus, hipDeviceAttributeMultiprocessorCount, dev);
        if (hipFuncSetAttribute((const void*)fwd_kernel, hipFuncAttributeMaxDynamicSharedMemorySize, LDS_BYTES) != hipSuccess) fprintf(stderr, "hipFuncSetAttribute failed\n");
        if (hipOccupancyMaxActiveBlocksPerMultiprocessor(&per_cu, (const void*)fwd_kernel, 512, LDS_BYTES) != hipSuccess || per_cu < 1) { fprintf(stderr, "occupancy query: %d\n", per_cu); per_cu = 1; }
        (void)hipGetLastError();
        grid_blocks = cus;
        if (n_in != 20 || ws_size < WS_END) fprintf(stderr, "kernel_launch: unexpected n_in %d / ws_size %zu\n", n_in, ws_size);
    }
    (void)hipMemsetAsync((char*)d_ws + WS_CTL, 0, CTL_ZERO_BYTES, stream);
    Params p{};
    for (int i = 0; i < 20; ++i) p.in[i] = (const float*)d_in[i];
    p.out = (float*)d_out; p.ws = (unsigned char*)d_ws;
    void* args[] = {&p};
    hipError_t e = hipLaunchCooperativeKernel((const void*)fwd_kernel, dim3(grid_blocks), dim3(512), args, LDS_BYTES, stream);
    if (e != hipSuccess) fprintf(stderr, "cooperative launch failed: %s (grid %d)\n", hipGetErrorString(e), grid_blocks);
}
```

```cpp
#include <hip/hip_runtime.h>
#include <hip/hip_cooperative_groups.h>
#include <cstdio>
#include <cstdint>
namespace cg = cooperative_groups;
namespace pg8 {
#define PG8_LAS __attribute__((address_space(3)))
typedef unsigned short bf16_t;
typedef short bf16x8 __attribute__((ext_vector_type(8)));
typedef float f32x4 __attribute__((ext_vector_type(4)));
typedef unsigned u32x4 __attribute__((ext_vector_type(4)));
constexpr int BM = 256, BK = 64, HALF = 128, HTB = HALF * BK * 2  , STAGE_BYTES = 8 * HTB, NXCD = 8, WGM = 8;

__host__ __device__ __forceinline__ int lds_byte(int r, int c) { const int st = (r >> 4) * 2 + (c >> 5), rr = r & 15, cc = c & 31, ob = rr * 64 + cc * 2; return st * 1024 + (ob ^ (((ob >> 9) & 1) << 5)); }
__host__ __device__ __forceinline__ void stage_rc(int b, int& R, int& C) { const int st = b / 1024, sb = b % 1024, swz = sb ^ (((sb >> 9) & 1) << 5); R = (st >> 1) * 16 + swz / 64; C = (st & 1) * 32 + (swz % 64) / 2; }
__host__ __device__ __forceinline__ int perm32(int rho) { const int n = rho >> 4, i = rho & 15; return 8 * (i >> 2) + 4 * n + (i & 3); }

struct Unit { int pm, pn, ks, kt; };
struct Gemm { const bf16_t* A; const bf16_t* Bt; int M, N, K; };

struct StaticOrder {
    int nM, nN, nwg, G, c;
    __host__ __device__ void init(int M, int N, int G_, int c_) { nM = M / BM; nN = N / BM; nwg = nM * nN; G = G_; c = c_; }
    __host__ __device__ bool next(int i, Unit& u) const {
        const long L = (long)i * G + c; if (L >= nwg) return false;
        int wgid = (int)L; { const int q = nwg / NXCD, r = nwg % NXCD, xcd = wgid % NXCD, off = wgid / NXCD; wgid = (xcd < r ? xcd * (q + 1) : r * (q + 1) + (xcd - r) * q) + off; }
        const int nig = WGM * nN, gid = wgid / nig, fm = gid * WGM, gsz = (nM - fm) < WGM ? (nM - fm) : WGM;
        u.pm = fm + ((wgid % nig) % gsz); u.pn = (wgid % nig) / gsz; u.ks = 0; u.kt = 0; return true;
    }
    __device__ __forceinline__ void a_ready(const Unit&) const {}
    __device__ __forceinline__ void done(const Unit&) const {}
};

__device__ __forceinline__ unsigned cvt_pk_bf16(float lo, float hi) { unsigned r; asm volatile("v_cvt_pk_bf16_f32 %0, %1, %2" : "=v"(r) : "v"(lo), "v"(hi)); return r; }
template <class Epi, class Sched, bool ALIGN_EPI = false, bool SP2 = false>
__device__ __forceinline__ void gemm_phase(PG8_LAS unsigned char* lds, const Gemm g, const Sched& S, const Epi& E) {
    int tid_ = threadIdx.x; asm volatile("" : "+v"(tid_));
    const int tid = tid_, wid = __builtin_amdgcn_readfirstlane(tid >> 6), lane = tid & 63, wr = wid >> 2, wc = wid & 3, fr = lane & 15, fq = lane >> 4;
    const int K = g.K;
    unsigned voffA[2], voffB[2];
#pragma unroll
    for (int i = 0; i < 2; ++i) { int R, C; stage_rc(tid * 16 + i * 8192, R, C); const int Rb = Epi::PERM ? ((R & ~31) + perm32(R & 31)) : R;
        voffA[i] = (unsigned)(R * K + C) * 2u; voffB[i] = (unsigned)(Rb * K + C) * 2u; }
    const size_t kstep = (size_t)(BK * 2);
    const size_t hstep = (size_t)HALF * K * 2;
    const size_t tstep = 2 * hstep;
    const unsigned ldsw = (unsigned)wid * 1024u;
    const int aoff = lds_byte(wr * 64 + fr, fq * 8), boff = lds_byte(wc * 32 + fr, fq * 8);
#define PG8_SA(b, h) (((b) * 2 + (h)) * HTB)
#define PG8_SB(b, h) ((4 + (b) * 2 + (h)) * HTB)
#define PG8_STAGE(bufoff, gbase, voff) do { _Pragma("unroll") for (int _i = 0; _i < 2; ++_i) \
        __builtin_amdgcn_global_load_lds((const unsigned*)((const char*)(gbase) + (voff)[_i]), (PG8_LAS unsigned*)(lds + (bufoff) + ldsw + _i * 8192), 16, 0, 0); } while (0)
#define PG8_LDA(dst, b, h) do { _Pragma("unroll") for (int m = 0; m < 4; ++m) _Pragma("unroll") for (int k = 0; k < 2; ++k) dst[m][k] = *(const PG8_LAS bf16x8*)(lds + PG8_SA(b, h) + aoff + m * 2048 + k * 1024); } while (0)
#define PG8_LDB(dst, b, h) do { _Pragma("unroll") for (int n = 0; n < 2; ++n) _Pragma("unroll") for (int k = 0; k < 2; ++k) dst[n][k] = *(const PG8_LAS bf16x8*)(lds + PG8_SB(b, h) + boff + n * 2048 + k * 1024); } while (0)
#define PG8_MMA(ai, bj, At, Bt) do { __builtin_amdgcn_s_setprio(1); _Pragma("unroll") for (int m = 0; m < 4; ++m) _Pragma("unroll") for (int n = 0; n < 2; ++n) _Pragma("unroll") for (int k = 0; k < 2; ++k) \
        acc[ai][bj][m][n] = __builtin_amdgcn_mfma_f32_16x16x32_bf16(Bt[n][k], At[m][k], acc[ai][bj][m][n], 0, 0, 0); __builtin_amdgcn_s_setprio(0); } while (0)
#define PG8_WAIT_V(n) asm volatile("s_waitcnt vmcnt(" #n ")" ::: "memory")
#define PG8_WAIT_L(n) asm volatile("s_waitcnt lgkmcnt(" #n ")" ::: "memory")
#define PG8_BAR __builtin_amdgcn_s_barrier()
#define PG8_SCHED __builtin_amdgcn_sched_barrier(0)
    Unit cur, nxt; int ui = 0;
    if (!S.next(0, cur)) return;
    f32x4 acc[2][2][4][2];
#pragma unroll
    for (int a = 0; a < 2; ++a)
#pragma unroll
        for (int b = 0; b < 2; ++b)
#pragma unroll
            for (int m = 0; m < 4; ++m)
#pragma unroll
                for (int n = 0; n < 2; ++n) acc[a][b][m][n] = (f32x4){0.f, 0.f, 0.f, 0.f};
    bf16x8 At[4][2], B0[2][2], B1[2][2];
    const char* cA = (const char*)g.A + (size_t)cur.pm * tstep + (size_t)cur.ks * 2; const char* cB = (const char*)g.Bt + (size_t)cur.pn * tstep + (size_t)cur.ks * 2;
    S.a_ready(cur);
    if constexpr (SP2) {
        PG8_STAGE(PG8_SB(0, 0), cB, voffB); PG8_STAGE(PG8_SB(0, 1), cB + hstep, voffB); PG8_STAGE(PG8_SA(0, 0), cA, voffA); PG8_STAGE(PG8_SA(0, 1), cA + hstep, voffA);
        if (wr == 1) PG8_BAR;
        PG8_WAIT_V(2); PG8_BAR;
        PG8_STAGE(PG8_SB(1, 0), cB + kstep, voffB); PG8_STAGE(PG8_SA(1, 0), cA + kstep, voffA); PG8_STAGE(PG8_SB(1, 1), cB + hstep + kstep, voffB);
        PG8_WAIT_V(6); PG8_BAR;
    } else {
        PG8_STAGE(PG8_SB(0, 0), cB, voffB); PG8_STAGE(PG8_SA(0, 0), cA, voffA); PG8_STAGE(PG8_SB(0, 1), cB + hstep, voffB); PG8_STAGE(PG8_SA(0, 1), cA + hstep, voffA);
        if (wr == 1) PG8_BAR;
        PG8_WAIT_V(4); PG8_BAR;
        PG8_STAGE(PG8_SB(1, 0), cB + kstep, voffB); PG8_STAGE(PG8_SA(1, 0), cA + kstep, voffA); PG8_STAGE(PG8_SB(1, 1), cB + hstep + kstep, voffB);
        PG8_WAIT_V(6); PG8_BAR;
    }
    for (;;) {
        const bool has_next = S.next(ui + 1, nxt);
        const char* nA = has_next ? (const char*)g.A + (size_t)nxt.pm * tstep + (size_t)nxt.ks * 2 : cA; const char* nB = has_next ? (const char*)g.Bt + (size_t)nxt.pn * tstep + (size_t)nxt.ks * 2 : cB;
        const int nt = (cur.kt ? cur.kt : K) / BK;
        for (int t = 0; t < nt; t += 2) {
            const bool last = (t == nt - 2);
            const char* a1 = cA + (size_t)(t + 1) * kstep;
            const char* a2 = last ? nA : cA + (size_t)(t + 2) * kstep; const char* b2 = last ? nB : cB + (size_t)(t + 2) * kstep;
            const char* a3 = a2 + kstep; const char* b3 = b2 + kstep;
            if (last && has_next) S.a_ready(nxt);
            if constexpr (SP2) {
            PG8_LDB(B0, 0, 0); PG8_LDB(B1, 0, 1); PG8_SCHED; PG8_LDA(At, 0, 0); PG8_STAGE(PG8_SA(1, 1), a1 + hstep, voffA);
            PG8_WAIT_V(8); PG8_WAIT_L(0); PG8_BAR; PG8_MMA(0, 0, At, B0); PG8_MMA(0, 1, At, B1); PG8_BAR; PG8_SCHED;
            PG8_LDA(At, 0, 1); PG8_STAGE(PG8_SB(0, 0), b2, voffB); PG8_STAGE(PG8_SB(0, 1), b2 + hstep, voffB); PG8_STAGE(PG8_SA(0, 0), a2, voffA);
            PG8_WAIT_V(8); PG8_WAIT_L(0); PG8_BAR; PG8_MMA(1, 0, At, B0); PG8_MMA(1, 1, At, B1); PG8_BAR; PG8_SCHED;
            PG8_LDB(B0, 1, 0); PG8_LDB(B1, 1, 1); PG8_SCHED; PG8_LDA(At, 1, 0); PG8_STAGE(PG8_SA(0, 1), a2 + hstep, voffA);
            PG8_WAIT_V(8); PG8_WAIT_L(0); PG8_BAR; PG8_MMA(0, 0, At, B0); PG8_MMA(0, 1, At, B1); PG8_BAR; PG8_SCHED;
            PG8_LDA(At, 1, 1); PG8_STAGE(PG8_SB(1, 0), b3, voffB); PG8_STAGE(PG8_SB(1, 1), b3 + hstep, voffB); PG8_STAGE(PG8_SA(1, 0), a3, voffA);
            PG8_WAIT_V(8); PG8_WAIT_L(0); PG8_BAR; PG8_MMA(1, 0, At, B0); PG8_MMA(1, 1, At, B1); PG8_BAR; PG8_SCHED;
            } else {
            PG8_LDB(B0, 0, 0); PG8_SCHED; PG8_LDA(At, 0, 0); PG8_STAGE(PG8_SA(1, 1), a1 + hstep, voffA);
            PG8_WAIT_L(8); PG8_BAR; PG8_WAIT_L(0); PG8_MMA(0, 0, At, B0); PG8_BAR; PG8_SCHED;
            PG8_LDB(B1, 0, 1); PG8_STAGE(PG8_SB(0, 0), b2, voffB);
            PG8_BAR; PG8_WAIT_L(0); PG8_MMA(0, 1, At, B1); PG8_BAR;
            PG8_LDA(At, 0, 1); PG8_STAGE(PG8_SA(0, 0), a2, voffA);
            PG8_BAR; PG8_WAIT_L(0); PG8_MMA(1, 0, At, B0); PG8_BAR; PG8_SCHED;
            PG8_STAGE(PG8_SB(0, 1), b2 + hstep, voffB);
            PG8_WAIT_V(6); PG8_BAR; PG8_MMA(1, 1, At, B1); PG8_BAR;
            PG8_LDB(B0, 1, 0); PG8_SCHED; PG8_LDA(At, 1, 0); PG8_STAGE(PG8_SA(0, 1), a2 + hstep, voffA);
            PG8_WAIT_L(8); PG8_BAR; PG8_WAIT_L(0); PG8_MMA(0, 0, At, B0); PG8_BAR; PG8_SCHED;
            PG8_LDB(B1, 1, 1); PG8_STAGE(PG8_SB(1, 0), b3, voffB);
            PG8_BAR; PG8_WAIT_L(0); PG8_MMA(0, 1, At, B1); PG8_BAR;
            PG8_LDA(At, 1, 1); PG8_STAGE(PG8_SA(1, 0), a3, voffA);
            PG8_BAR; PG8_WAIT_L(0); PG8_MMA(1, 0, At, B0); PG8_BAR; PG8_SCHED;
            PG8_STAGE(PG8_SB(1, 1), b3 + hstep, voffB);
            PG8_WAIT_V(6); PG8_BAR; PG8_MMA(1, 1, At, B1); PG8_BAR;
            }
        }
        if constexpr (ALIGN_EPI) { if (wr == 0) PG8_BAR; }
        if constexpr (!Epi::AFTER_DRAIN) { E(acc, cur, wr, wc, fr, fq); S.done(cur); }
        if (!has_next) break;
#pragma unroll
        for (int a = 0; a < 2; ++a)
#pragma unroll
            for (int b = 0; b < 2; ++b)
#pragma unroll
                for (int m = 0; m < 4; ++m)
#pragma unroll
                    for (int n = 0; n < 2; ++n) acc[a][b][m][n] = (f32x4){0.f, 0.f, 0.f, 0.f};
        cur = nxt; cA = nA; cB = nB; ++ui;
        if constexpr (ALIGN_EPI) { if (wr == 1) PG8_BAR; }
    }
    PG8_WAIT_V(0);
    if constexpr (!ALIGN_EPI) { if (wr == 0) PG8_BAR; }
    PG8_BAR;
    if constexpr (Epi::AFTER_DRAIN) { E.fused(acc, cur, wr, wc, fr, fq, lds, wid, lane); S.done(cur); }
#undef PG8_SA
#undef PG8_SB
#undef PG8_STAGE
#undef PG8_LDA
#undef PG8_LDB
#undef PG8_MMA
#undef PG8_WAIT_V
#undef PG8_WAIT_L
#undef PG8_BAR
#undef PG8_SCHED
}
}

using namespace pg8;
#define LAS __attribute__((address_space(3)))
#define DI __device__ __forceinline__
typedef short s16x4 __attribute__((ext_vector_type(4)));
typedef short v4i16_t __attribute__((ext_vector_type(4)));
typedef float f32x16 __attribute__((ext_vector_type(16)));
typedef float f32x2_t __attribute__((ext_vector_type(2)));
typedef __bf16 bf16x2_t __attribute__((ext_vector_type(2)));
typedef unsigned u32x2 __attribute__((ext_vector_type(2)));

constexpr int NP = 16384, NS = 1024, NT = 17408, DM = 1024, DFF = 2816;
constexpr float EPS = 1e-6f;
constexpr float LOG2E = 1.4426950408889634f;
constexpr float QSCALE = 0.125f * LOG2E;
constexpr float NEGBIG = -1e30f;

constexpr size_t O_Y = 0;
constexpr size_t O_PSK = 17825792;
constexpr size_t O_PSV = 17891328;
constexpr size_t O_PDK = 17956864;
constexpr size_t O_PDV = 21102592;
constexpr size_t O_PMK = 24248320;
constexpr size_t O_PMV = 24510464;
constexpr size_t O_SSK = 24772608;
constexpr size_t O_SSV = 26869760;
constexpr size_t O_SDK = 28966912;
constexpr size_t O_SDV = 129630208;

constexpr size_t MiB = 1u << 20;
constexpr size_t WS_ROT = 1 * MiB;
constexpr size_t WS_WIN = 4 * MiB;
constexpr size_t WS_WO = 10 * MiB;
constexpr size_t WS_WGU = 12 * MiB;
constexpr size_t WS_WD = 24 * MiB;
constexpr size_t WS_AALL = 32 * MiB;
constexpr size_t WS_ZQ = 68 * MiB;
constexpr size_t WS_KA = 102 * MiB;
constexpr size_t WS_VA = 106 * MiB;
constexpr size_t WS_KB = 110 * MiB;
constexpr size_t WS_VB = 122 * MiB;
constexpr size_t WS_MK = 134 * MiB;
constexpr size_t WS_MV = 135 * MiB;
constexpr size_t WS_CAT = 136 * MiB;
constexpr size_t WS_BPO = 170 * MiB;
constexpr size_t WS_BPM = 210 * MiB;
constexpr size_t WS_T = 214 * MiB;
constexpr size_t WS_SS = 250 * MiB;
constexpr size_t WS_ACT = 252 * MiB;
constexpr size_t WS_PART = 348 * MiB;
constexpr size_t WS_END = 392 * MiB;

constexpr int LDS_BYTES = 131072 + 256;
constexpr size_t WS_CTL = 0, CTL_ZERO_BYTES = 65536;

__device__ const double INVF[32] = {
    1.0, 0.7498942093324559, 0.5623413251903491, 0.4216965034285822, 0.31622776601683794, 0.23713737056616552, 0.1778279410038923, 0.1333521432163324,
    0.1, 0.07498942093324558, 0.05623413251903491, 0.042169650342858224, 0.03162277660168379, 0.023713737056616554, 0.01778279410038923, 0.01333521432163324,
    0.01, 0.007498942093324558, 0.005623413251903491, 0.004216965034285823, 0.0031622776601683794, 0.0023713737056616554, 0.0017782794100389228, 0.001333521432163324,
    0.001, 0.0007498942093324559, 0.0005623413251903491, 0.00042169650342858224, 0.00031622776601683794, 0.00023713737056616554, 0.00017782794100389227, 0.0001333521432163324};

DI unsigned pk(float lo, float hi) { f32x2_t v = {lo, hi}; bf16x2_t b = __builtin_convertvector(v, bf16x2_t); return __builtin_bit_cast(unsigned, b); }
DI u32x2 pack4(f32x4 v) { u32x2 r; r.x = pk(v[0], v[1]); r.y = pk(v[2], v[3]); return r; }
DI bf16x8 pack8(f32x4 a, f32x4 b) { u32x4 r; r.x = pk(a[0], a[1]); r.y = pk(a[2], a[3]); r.z = pk(b[0], b[1]); r.w = pk(b[2], b[3]); return __builtin_bit_cast(bf16x8, r); }
DI f32x4 unpack4(u32x2 w) { f32x4 r; r[0] = __builtin_bit_cast(float, w.x << 16); r[1] = __builtin_bit_cast(float, w.x & 0xffff0000u); r[2] = __builtin_bit_cast(float, w.y << 16); r[3] = __builtin_bit_cast(float, w.y & 0xffff0000u); return r; }
DI float wave_sum(float v) {
#pragma unroll
    for (int o = 1; o < 64; o <<= 1) v += __shfl_xor(v, o);
    return v;
}
DI float ex2(float x) { return __builtin_amdgcn_exp2f(x); }
DI int fresh_lane() { return (int)__builtin_amdgcn_mbcnt_hi(~0u, __builtin_amdgcn_mbcnt_lo(~0u, 0u)); }

template <int MODE>
DI void tr_item(const float* W0, const float* W1, int K, int NV, int ld, bf16_t* WT, int row_off, LAS float* scr, int item, int lane) {
    const int nblk = NV / 32, kb = item / nblk, nb = item % nblk, k0 = 64 * kb, n0 = 32 * nb;
    const int v = n0 + (lane & 31);
    const float* src = W0; int col = v;
    if (MODE == 1) { const int hb = v >> 6, vv = v & 63; col = hb * 64 + ((vv >> 2) & 1) * 32 + (vv >> 3) * 4 + (vv & 3); }
    if (MODE == 2) { src = ((v >> 2) & 1) ? W1 : W0; col = (v >> 3) * 4 + (v & 3); }
    float tv_[32];
#pragma unroll
    for (int i = 0; i < 32; ++i) tv_[i] = src[(size_t)(k0 + 2 * i + (lane >> 5)) * ld + col];
#pragma unroll
    for (int i = 0; i < 32; ++i) scr[(2 * i + (lane >> 5)) * 33 + (lane & 31)] = tv_[i];
    asm volatile("s_waitcnt lgkmcnt(0)" ::: "memory");
    const int c = lane & 7;
#pragma unroll
    for (int j = 0; j < 4; ++j) { const int n = (lane >> 3) + 8 * j; const LAS float* s = scr + (8 * c) * 33 + n;
        u32x4 o; o.x = pk(s[0 * 33], s[1 * 33]); o.y = pk(s[2 * 33], s[3 * 33]); o.z = pk(s[4 * 33], s[5 * 33]); o.w = pk(s[6 * 33], s[7 * 33]);
        *(u32x4*)(WT + (size_t)(row_off + n0 + n) * K + k0 + 8 * c) = o; }
    asm volatile("s_waitcnt lgkmcnt(0)" ::: "memory");
}

DI void copy_shift(const float* src, float* dst, int nper, int srcoff, size_t stride, int gt, int NGT) {
    const int total = 128 * nper;
    for (int idx0 = gt; idx0 < total; idx0 += 4 * NGT) {
        f32x4 v[4]; f32x4* d[4];
#pragma unroll
        for (int u = 0; u < 4; ++u) {
            const int idx = idx0 + u * NGT; const int ic = idx < total ? idx : total - 1;
            const int n = ic / nper, o = ic - n * nper;
            v[u] = __builtin_nontemporal_load((const f32x4*)(src + (size_t)n * stride + srcoff) + o);
            d[u] = (f32x4*)(dst + (size_t)n * stride) + o;
        }
#pragma unroll
        for (int u = 0; u < 4; ++u) if (idx0 + u * NGT < total) __builtin_nontemporal_store(v[u], d[u]);
    }
}

struct Sched1 {
    StaticOrder so; int G, c;
    __device__ void init(int G_, int c_) { so.init(NT, 2048, G_, c_); G = G_; c = c_; }
    __device__ bool next(int i, Unit& u) const {
        const int L = i * G + c;
        if (L < 544) return so.next(i, u);
        if (L >= 552) return false;
        const int e = L - 544; u.pm = 68 + (e >> 1); u.pn = 8 + (e & 1); u.ks = 0; u.kt = 0; return true;
    }
    DI void a_ready(const Unit&) const {}
    DI void done(const Unit&) const {}
};

struct SchedSK {
    StaticOrder so; int c, nsl;
    __device__ void init(int G_, int c_, int K) { so.init(NP, 1024, G_, c_); c = c_; nsl = K / 256; }
    __device__ bool next(int i, Unit& u) const {
        if (i == 0) return so.next(0, u);
        if (i > 1 || c >= 16 * nsl) return false;
        const int tile = c / nsl, sl = c - tile * nsl;
        u.pm = 64 + (tile >> 2); u.pn = tile & 3; u.ks = sl * 256; u.kt = 256; return true;
    }
    DI void a_ready(const Unit&) const {}
    DI void done(const Unit&) const {}
};

struct EpiQKV {
    static constexpr bool PERM = true, AFTER_DRAIN = false;
    unsigned char* ws; float* out; const f32x4* rot;
    DI void operator()(const f32x4 (&acc)[2][2][4][2], const Unit& u, int wr, int wc, int fr, int fq) const {
        const int g4 = 4 * ((wc & 1) * 4 + fq), hsub = wc >> 1;
        if (u.pn < 8) {
#pragma unroll
            for (int ai = 0; ai < 2; ++ai)
#pragma unroll
                for (int m = 0; m < 4; ++m) {
                    const int row = u.pm * 256 + ai * 128 + wr * 64 + m * 16 + fr;
                    const bool samp = row >= NP;
                    const int ti = samp ? 4096 + (row & 7) : (row & 4095);
                    const f32x4 cs0 = rot[(ti * 32 + g4) >> 1], cs1 = rot[((ti * 32 + g4) >> 1) + 1];
#pragma unroll
                    for (int bj = 0; bj < 2; ++bj) {
                        const int cb = 2 * u.pn + bj;
                        f32x4 x1 = acc[ai][bj][m][0], x2 = acc[ai][bj][m][1];
                        const bool isrot = (cb <= 3) || (cb >= 5 && cb <= 10);
                        if (isrot) {
                            f32x4 o1, o2;
                            o1[0] = x1[0] * cs0[0] - x2[0] * cs0[1]; o2[0] = x2[0] * cs0[0] + x1[0] * cs0[1];
                            o1[1] = x1[1] * cs0[2] - x2[1] * cs0[3]; o2[1] = x2[1] * cs0[2] + x1[1] * cs0[3];
                            o1[2] = x1[2] * cs1[0] - x2[2] * cs1[1]; o2[2] = x2[2] * cs1[0] + x1[2] * cs1[1];
                            o1[3] = x1[3] * cs1[2] - x2[3] * cs1[3]; o2[3] = x2[3] * cs1[2] + x1[3] * cs1[3];
                            x1 = o1; x2 = o2;
                        }
                        if (cb <= 2 || (cb >= 5 && cb <= 7) || cb >= 14) {
                            const int col = cb <= 2 ? (2 * cb + hsub) * 64 : (cb <= 7 ? 384 + (2 * (cb - 5) + hsub) * 64 : 768 + (2 * (cb - 14) + hsub) * 64);
                            x1 = x1 * QSCALE; x2 = x2 * QSCALE;
                            bf16_t* dst = (bf16_t*)(ws + WS_ZQ) + (size_t)row * 1024 + col + g4;
                            *(u32x2*)dst = pack4(x1); *(u32x2*)(dst + 32) = pack4(x2);
                        } else {
                            const bool isA = cb <= 4; const bool isK = (cb == 3) || (cb >= 8 && cb <= 10);
                            const int head = isA ? hsub : (isK ? 2 * (cb - 8) + hsub : 2 * (cb - 11) + hsub);
                            const int nh = isA ? 2 : 6;
                            if (!samp) {
                                bf16_t* base = (bf16_t*)(ws + (isA ? (isK ? WS_KA : WS_VA) : (isK ? WS_KB : WS_VB)));
                                bf16_t* dst = base + (size_t)row * (nh * 64) + head * 64 + g4;
                                *(u32x2*)dst = pack4(x1); *(u32x2*)(dst + 32) = pack4(x2);
                                const int b = row >> 12, t = row & 4095, w0 = isA ? 3968 : 2048;
                                if (t >= w0) {
                                    float* o = out + (isA ? (isK ? O_PSK : O_PSV) : (isK ? O_PDK : O_PDV)) + ((size_t)(b * (4096 - w0) + (t - w0)) * nh + head) * 64 + g4;
                                    *(f32x4*)o = x1; *(f32x4*)(o + 32) = x2;
                                }
                            } else {
                                const int n = (row - NP) >> 3, i = row & 7, Lw = isA ? 128 : 2048;
                                float* o = out + (isA ? (isK ? O_SSK : O_SSV) : (isK ? O_SDK : O_SDV)) + ((size_t)(n * Lw + Lw - 8 + i) * nh + head) * 64 + g4;
                                *(f32x4*)o = x1; *(f32x4*)(o + 32) = x2;
                            }
                        }
                    }
                }
        } else {
#pragma unroll
            for (int ai = 0; ai < 2; ++ai)
#pragma unroll
                for (int m = 0; m < 4; ++m) {
                    const int row = (u.pm - 68) * 256 + ai * 128 + wr * 64 + m * 16 + fr;
#pragma unroll
                    for (int bj = 0; bj < 2; ++bj) {
                        const int cb = 2 * (u.pn - 8) + bj; const bool isK = cb < 2; const int head = 2 * (cb & 1) + hsub;
                        const f32x4 x1 = acc[ai][bj][m][0], x2 = acc[ai][bj][m][1];
                        bf16_t* dst = (bf16_t*)(ws + (isK ? WS_MK : WS_MV)) + (size_t)row * 256 + head * 64 + g4;
                        *(u32x2*)dst = pack4(x1); *(u32x2*)(dst + 32) = pack4(x2);
                        float* o = out + (isK ? O_PMK : O_PMV) + (size_t)row * 256 + head * 64 + g4;
                        *(f32x4*)o = x1; *(f32x4*)(o + 32) = x2;
                    }
                }
        }
    }
};

struct EpiT {
    static constexpr bool PERM = true, AFTER_DRAIN = false;
    bf16_t* T; float* SS; float* PART;
    DI void operator()(const f32x4 (&acc)[2][2][4][2], const Unit& u, int wr, int wc, int fr, int fq) const {
        if (u.kt) {
            float* P = PART + (size_t)(u.ks >> 8) * 1024 * 1024;
#pragma unroll
            for (int ai = 0; ai < 2; ++ai)
#pragma unroll
                for (int m = 0; m < 4; ++m) {
                    const int row = (u.pm - 64) * 256 + ai * 128 + wr * 64 + m * 16 + fr;
#pragma unroll
                    for (int bj = 0; bj < 2; ++bj) {
                        float* d = P + (size_t)row * 1024 + u.pn * 256 + bj * 128 + wc * 32 + fq * 8;
                        *(f32x4*)d = acc[ai][bj][m][0]; *(f32x4*)(d + 4) = acc[ai][bj][m][1];
                    }
                }
            return;
        }
#pragma unroll
        for (int ai = 0; ai < 2; ++ai)
#pragma unroll
            for (int m = 0; m < 4; ++m) {
                const int row = u.pm * 256 + ai * 128 + wr * 64 + m * 16 + fr;
                float s = 0.f;
#pragma unroll
                for (int bj = 0; bj < 2; ++bj) {
                    const f32x4 v0 = acc[ai][bj][m][0], v1 = acc[ai][bj][m][1];
                    s += (v0[0] * v0[0] + v0[1] * v0[1]) + (v0[2] * v0[2] + v0[3] * v0[3]) + (v1[0] * v1[0] + v1[1] * v1[1]) + (v1[2] * v1[2] + v1[3] * v1[3]);
                    u32x4 w; w.x = pk(v0[0], v0[1]); w.y = pk(v0[2], v0[3]); w.z = pk(v1[0], v1[1]); w.w = pk(v1[2], v1[3]);
                    *(u32x4*)(T + (size_t)row * 1024 + u.pn * 256 + bj * 128 + wc * 32 + fq * 8) = w;
                }
                s += __shfl_xor(s, 16); s += __shfl_xor(s, 32);
                if (fq == 0) SS[(size_t)(u.pn * 4 + wc) * NT + row] = s;
            }
    }
};

struct EpiAct {
    static constexpr bool PERM = true, AFTER_DRAIN = false;
    bf16_t* ACT;
    DI void operator()(const f32x4 (&acc)[2][2][4][2], const Unit& u, int wr, int wc, int fr, int fq) const {
#pragma unroll
        for (int ai = 0; ai < 2; ++ai)
#pragma unroll
            for (int m = 0; m < 4; ++m) {
                const int row = u.pm * 256 + ai * 128 + wr * 64 + m * 16 + fr;
#pragma unroll
                for (int bj = 0; bj < 2; ++bj) {
                    const f32x4 g = acc[ai][bj][m][0], up = acc[ai][bj][m][1];
                    f32x4 a;
#pragma unroll
                    for (int e = 0; e < 4; ++e) a[e] = g[e] * __builtin_amdgcn_rcpf(1.f + ex2(-g[e] * LOG2E)) * up[e];
                    *(u32x2*)(ACT + (size_t)row * DFF + u.pn * 128 + bj * 64 + wc * 16 + fq * 4) = pack4(a);
                }
            }
    }
};

#define MFMA32(a, b, c) __builtin_amdgcn_mfma_f32_32x32x16_bf16((a), (b), (c), 0, 0, 0)
DI s16x4 vtr(const LAS unsigned char* p) { return __builtin_bit_cast(s16x4, __builtin_amdgcn_ds_read_tr16_b64_v4i16((LAS v4i16_t*)p)); }

template <bool F32>
DI void load_chunk(f32x4 (&rk)[8], f32x4 (&rv)[8], u32x4 (&bk)[4], u32x4 (&bv)[4], int f0,
                   const void* kb0, const void* kb1, const void* vb0, const void* vb1, int pitch, int L, int c, int rr, int fmax, int lane) {
    if (!F32) {
        const int row0 = c + rr * (f0 + (lane >> 3));
        const bf16_t* kp = (const bf16_t*)kb0 + (size_t)row0 * pitch + 8 * (lane & 7);
        const bf16_t* vp = (const bf16_t*)vb0 + (size_t)row0 * pitch + 8 * (lane & 7);
        const size_t js = (size_t)8 * rr * pitch;
#pragma unroll
        for (int j = 0; j < 4; ++j) { bk[j] = *(const u32x4*)(kp + j * js); bv[j] = *(const u32x4*)(vp + j * js); }
    } else {
#pragma unroll
        for (int j = 0; j < 8; ++j) {
            const int fu = f0 + 4 * j + (lane >> 4); const int fk = fu > fmax ? fmax : fu;
            const int R = c + rr * fk; const bool lo = R < L;
            const size_t off = (size_t)(lo ? R : R - 8) * pitch + 4 * (lane & 15);
            rk[j] = *(const f32x4*)((lo ? (const float*)kb0 : (const float*)kb1) + off);
            rv[j] = *(const f32x4*)((lo ? (const float*)vb0 : (const float*)vb1) + off);
        }
    }
}

template <bool F32>
DI void attn_core(const bf16_t* ZQ, int qrow, int qcol, int qf, int W,
                  const void* kb0, const void* kb1, const void* vb0, const void* vb1, int pitch, int L, int c, int rr, int fmax, int kf0, int nch, int cpy,
                  LAS unsigned char* klds, int lane, float& m_out, float& l_out, f32x16& O0, f32x16& O1) {
    const int r = lane & 31, h = lane >> 5;
    LAS unsigned char* vlds = klds + 4608;
    bf16x8 qfr[4];
    { const bf16_t* qp = ZQ + (size_t)qrow * 1024 + qcol + 8 * h;
#pragma unroll
      for (int st = 0; st < 4; ++st) qfr[st] = *(const bf16x8*)(qp + 16 * st); }
    float m = NEGBIG, l = 0.f;
#pragma unroll
    for (int i = 0; i < 16; ++i) { O0[i] = 0.f; O1[i] = 0.f; }
    const int i16 = lane & 15;
    const LAS unsigned char* vrd = vlds + (4 * h + (i16 >> 2)) * 144 + (16 * ((lane >> 4) & 1) + 4 * (i16 & 3)) * 2;
    const LAS unsigned char* krd = klds + r * 144 + 16 * h;
    const int wof = F32 ? (lane >> 4) * 144 + (lane & 15) * 8 : (lane >> 3) * 144 + (lane & 7) * 16;
    f32x4 rk[8], rv[8]; u32x4 bk[4], bv[4];
    int ch = 0;
    while (ch < nch && kf0 + 32 * ch + 31 < 0) ++ch;
    if (ch < nch) load_chunk<F32>(rk, rv, bk, bv, kf0 + 32 * ch, kb0, kb1, vb0, vb1, pitch, L, c, rr, fmax, lane);
    for (; ch < nch; ++ch) {
        const int f0 = kf0 + 32 * ch;
        if (!F32) {
#pragma unroll
            for (int j = 0; j < 4; ++j) { *(LAS u32x4*)(klds + wof + j * 8 * 144) = bk[j]; *(LAS u32x4*)(vlds + wof + j * 8 * 144) = bv[j]; }
        } else {
#pragma unroll
            for (int j = 0; j < 8; ++j) { *(LAS u32x2*)(klds + wof + j * 4 * 144) = pack4(rk[j]); *(LAS u32x2*)(vlds + wof + j * 4 * 144) = pack4(rv[j]); }
            if (cpy) {
#pragma unroll
                for (int j = 0; j < 8; ++j) {
                    const int fu = f0 + 4 * j + (lane >> 4); const int R = c + rr * fu;
                    const bool w = (fu <= fmax) && (R >= 8) && (R < 2048) && (cpy == 1 || (R >= 1536 && (R & 15) >= 8));
                    if (w) { const size_t off = (size_t)(R - 8) * pitch + 4 * (lane & 15);
                        __builtin_nontemporal_store(rk[j], (f32x4*)((float*)kb1 + off)); __builtin_nontemporal_store(rv[j], (f32x4*)((float*)vb1 + off)); }
                }
            }
        }
        if (ch + 1 < nch) load_chunk<F32>(rk, rv, bk, bv, f0 + 32, kb0, kb1, vb0, vb1, pitch, L, c, rr, fmax, lane);
        bf16x8 kfr[4];
#pragma unroll
        for (int st = 0; st < 4; ++st) kfr[st] = *(const LAS bf16x8*)(krd + 32 * st);
        f32x16 S;
#pragma unroll
        for (int i = 0; i < 16; ++i) S[i] = 0.f;
#pragma unroll
        for (int st = 0; st < 4; ++st) S = MFMA32(kfr[st], qfr[st], S);
        float mx = NEGBIG;
#pragma unroll
        for (int i = 0; i < 16; ++i) {
            const int f = f0 + (i & 3) + 8 * (i >> 2) + 4 * h;
            const int dist = qf - f;
            const bool ok = (f >= 0) && ((unsigned)dist <= (unsigned)W);
            S[i] = ok ? S[i] : NEGBIG;
            mx = fmaxf(mx, S[i]);
        }
        mx = fmaxf(mx, __shfl_xor(mx, 32));
        const float mn = fmaxf(m, mx);
        const float alpha = ex2(m - mn);
        m = mn;
        float rs = 0.f;
#pragma unroll
        for (int i = 0; i < 16; ++i) { S[i] = ex2(S[i] - mn); rs += S[i]; }
        rs += __shfl_xor(rs, 32);
        l = l * alpha + rs;
#pragma unroll
        for (int i = 0; i < 16; ++i) { O0[i] *= alpha; O1[i] *= alpha; }
        u32x4 p0, p1;
        p0.x = pk(S[0], S[1]); p0.y = pk(S[2], S[3]); p0.z = pk(S[4], S[5]); p0.w = pk(S[6], S[7]);
        p1.x = pk(S[8], S[9]); p1.y = pk(S[10], S[11]); p1.z = pk(S[12], S[13]); p1.w = pk(S[14], S[15]);
        const bf16x8 pf0 = __builtin_bit_cast(bf16x8, p0), pf1 = __builtin_bit_cast(bf16x8, p1);
        bf16x8 vf[2][2];
#pragma unroll
        for (int dt = 0; dt < 2; ++dt)
#pragma unroll
            for (int s = 0; s < 2; ++s) {
                const s16x4 lo = vtr(vrd + (16 * s) * 144 + 64 * dt), hi = vtr(vrd + (16 * s + 8) * 144 + 64 * dt);
                vf[dt][s] = __builtin_shufflevector(lo, hi, 0, 1, 2, 3, 4, 5, 6, 7);
            }
        O0 = MFMA32(vf[0][0], pf0, O0); O0 = MFMA32(vf[0][1], pf1, O0);
        O1 = MFMA32(vf[1][0], pf0, O1); O1 = MFMA32(vf[1][1], pf1, O1);
    }
    m_out = m; l_out = l;
}

#define XB_TMO      128
#define XB_XCNT(j)  (256  + 64 * (j))
#define XB_XSUB(j)  (1280 + 64 * (j))
#define XB_XGEN(j)  (2304 + 64 * (j))
#define XB_TOP      3328
#define XB_TOPGEN   3392
#define XCD_BAR_WORDS 3456
#define XB_SPIN_CAP (1u << 18)

__device__ __forceinline__ unsigned xb_ld(unsigned* p)              { return __hip_atomic_load(p, __ATOMIC_RELAXED, __HIP_MEMORY_SCOPE_AGENT); }
__device__ __forceinline__ unsigned xb_add(unsigned* p, unsigned v) { return __hip_atomic_fetch_add(p, v, __ATOMIC_RELAXED, __HIP_MEMORY_SCOPE_AGENT); }
__device__ __forceinline__ unsigned xb_xcc_id() { return (unsigned)__builtin_amdgcn_s_getreg((3 << 11) | 20) & 0xFu; }
#define XB_SPIN(cond, bar) do { unsigned _sp = 0; while (cond) { __builtin_amdgcn_s_sleep(1); \
    if ((++_sp & 255u) == 0u) { if (xb_ld(&(bar)[XB_TMO])) break; if (_sp > XB_SPIN_CAP) { atomicAdd(&(bar)[XB_TMO], 1u); break; } } } } while (0)

struct XcdBarrier {
    unsigned* bar; unsigned x;
    volatile LAS unsigned* st;
};

__device__ __forceinline__ XcdBarrier xcd_barrier_post(unsigned* bar, volatile LAS unsigned* st) {
    XcdBarrier b; b.bar = bar; b.x = xb_xcc_id(); b.st = st;
    if (threadIdx.x == 0) (void)xb_add(&bar[XB_XCNT(b.x)], 1u);
    return b;
}
__device__ __forceinline__ void xcd_barrier_complete(unsigned* bar, unsigned x, unsigned& nloc, unsigned& nx) {
    const unsigned G = gridDim.x * gridDim.y * gridDim.z;
    unsigned sum, cnt, mine, sp = 0u;
    for (;;) {
        sum = 0u; cnt = 0u; mine = 0u;
#pragma unroll
        for (unsigned j = 0; j < 16; ++j) { const unsigned c = xb_ld(&bar[XB_XCNT(j)]); sum += c; cnt += (c > 0u) ? 1u : 0u; mine = (j == x) ? c : mine; }
        if (sum == G) break;
        __builtin_amdgcn_s_sleep(1);
        if ((++sp & 255u) == 0u) { if (xb_ld(&bar[XB_TMO])) break; if (sp > XB_SPIN_CAP) { atomicAdd(&bar[XB_TMO], 1u); break; } }
    }
    nloc = mine > 0u ? mine : 1u; nx = cnt > 0u ? cnt : 1u;
}

__device__ __forceinline__ void xcd_barrier(const XcdBarrier& b) {
    asm volatile("s_waitcnt vmcnt(0)" ::: "memory");
    __syncthreads();
    if (threadIdx.x == 0) {
        unsigned* bar = b.bar;
        __builtin_amdgcn_s_waitcnt(0);
        unsigned nloc = b.st[0], nx = b.st[1];
        if (nloc == 0u) { xcd_barrier_complete(bar, b.x, nloc, nx); b.st[0] = nloc; b.st[1] = nx; }
        const unsigned old = xb_add(&bar[XB_XSUB(b.x)], 1u);
        const unsigned gen = old / nloc;
        if (old + 1u == (gen + 1u) * nloc) {
            __builtin_amdgcn_fence(__ATOMIC_RELEASE, "agent");
            asm volatile("s_waitcnt vmcnt(0)" ::: "memory");
            const unsigned og = xb_add(&bar[XB_TOP], 1u);
            const unsigned tg = og / nx;
            if (og + 1u == (tg + 1u) * nx) xb_add(&bar[XB_TOPGEN], 1u);
            else XB_SPIN(xb_ld(&bar[XB_TOPGEN]) == tg, bar);
            __builtin_amdgcn_fence(__ATOMIC_ACQUIRE, "agent");
            xb_add(&bar[XB_XGEN(b.x)], 1u);
            asm volatile("s_waitcnt vmcnt(0)" ::: "memory");
        } else {
            XB_SPIN(xb_ld(&bar[XB_XGEN(b.x)]) == gen, bar);
            __builtin_amdgcn_fence(__ATOMIC_ACQUIRE, "agent");
            asm volatile("s_waitcnt vmcnt(0)" ::: "memory");
        }
    }
    __syncthreads();
}

struct BgCopy { const float* src; float* dst; };
DI void bg_copy_all(const BgCopy& B, int wave, int) {
    const int lane = (int)__builtin_amdgcn_mbcnt_hi(~0u, __builtin_amdgcn_mbcnt_lo(~0u, 0u));
    const f32x4* sp = (const f32x4*)B.src + lane + (size_t)wave * 768; f32x4* dp = (f32x4*)B.dst + lane + (size_t)wave * 768;
    const int nk = (255 - wave + 7) >> 3;
    for (int q = 0; q < 8; ++q) {
        f32x4 t[48];
#pragma unroll
        for (int cc = 0; cc < 4; ++cc) { const int j = 4 * q + cc; const f32x4* s_ = sp + (size_t)(j < nk ? j : nk - 1) * 6144;
#pragma unroll
            for (int i = 0; i < 12; ++i) t[12 * cc + i] = __builtin_nontemporal_load(s_ + 64 * i); }
#pragma unroll
        for (int cc = 0; cc < 4; ++cc) { const int j = 4 * q + cc; if (j < nk) { f32x4* d_ = dp + (size_t)j * 6144;
#pragma unroll
            for (int i = 0; i < 12; ++i) __builtin_nontemporal_store(t[12 * cc + i], d_ + 64 * i); } }
    }
}
template <class Base> struct SchedBg {
    Base base; BgCopy bg; int wave, lane, my_round; mutable int idx;
    DI bool next(int i, Unit& u) const { return base.next(i, u); }
    DI void a_ready(const Unit&) const {}
    DI void done(const Unit&) const { if (idx++ == my_round) bg_copy_all(bg, wave, lane); }
};

struct Params { const float* in[20]; float* out; unsigned char* ws; };
DI void norm_row(const float* xp, const float* xs, const float* mp, const float* gpre, bf16_t* AALL, int row, int lane) {
    const float* xr = row < NP ? xp + (size_t)row * 1024 : (row < NT ? xs + (size_t)(row - NP) * 1024 : mp + (size_t)(row - NT) * 1024);
    f32x4 v[4]; float s = 0.f;
#pragma unroll
    for (int j = 0; j < 4; ++j) { v[j] = ((const f32x4*)xr)[lane + 64 * j]; s += (v[j][0] * v[j][0] + v[j][1] * v[j][1]) + (v[j][2] * v[j][2] + v[j][3] * v[j][3]); }
    if (row < NT) {
        s = wave_sum(s); const float rstd = 1.0f / sqrtf(s * (1.f / 1024.f) + EPS);
#pragma unroll
        for (int j = 0; j < 4; ++j) { const f32x4 g = ((const f32x4*)gpre)[lane + 64 * j]; v[j] = v[j] * rstd * g; }
    }
#pragma unroll
    for (int j = 0; j < 4; ++j) *(u32x2*)(AALL + (size_t)row * 1024 + 4 * lane + 256 * j) = pack4(v[j]);
}
struct SchedX {
    int c;
    DI bool next(int i, Unit& u) const {
        if (i != 0) return false;
        if (c < 32) { u.pm = 64 + (c >> 3); u.pn = c & 7; } else { const int e = c - 32; u.pm = 68 + (e >> 1); u.pn = 8 + (e & 1); }
        u.ks = 0; u.kt = 0; return true;
    }
    DI void a_ready(const Unit&) const {}
    DI void done(const Unit&) const {}
};


constexpr int U_SB2 = 128 * 6 * 8, U_SB1 = 128 * 6 * 4, U_SB0 = 128 * 6, U_SA = 128 * 2, U_SX = 128 * 4;
constexpr int U_PB = 4 * 6 * 3 * 128, U_PA = 4 * 6 * 128, U_PX = 4 * 4 * 128;
constexpr int U_S_END = U_SB2 + U_SB1 + U_SB0 + U_SA + U_SX;
constexpr int U_TOTAL = U_S_END + U_PB + U_PA + U_PX;

DI void attn_unit(const Params& p, int uid, int lane, LAS unsigned char* vlds) {
    unsigned char* ws = p.ws;
    const bf16_t* ZQ = (const bf16_t*)(ws + WS_ZQ);
    bf16_t* CAT = (bf16_t*)(ws + WS_CAT);
    bf16_t* BPO = (bf16_t*)(ws + WS_BPO);
    f32x2_t* BPM = (f32x2_t*)(ws + WS_BPM);
    const int r = lane & 31, h = lane >> 5;
    bool qvalid = true; int qrow = 0, qcol = 0, qf = 0, head = 0;
    int mode = 0  , pi = 0, W = 128, pitch = 0, L = 0, c = 0, rr = 1, fmax = 0, kf0 = 0, nch = 5;
    const void *kb0 = nullptr, *kb1 = nullptr, *vb0 = nullptr, *vb1 = nullptr;
    int cpy = 0;
    float m, l; f32x16 O0, O1;
    if (uid < U_S_END) {
        int u;
        { const int n_ = uid / 84, lo_ = uid - n_ * 84;
          u = lo_ < 48 ? n_ * 48 + lo_ : (lo_ < 72 ? U_SB2 + n_ * 24 + (lo_ - 48) : (lo_ < 78 ? U_SB2 + U_SB1 + n_ * 6 + (lo_ - 72) : (lo_ < 80 ? U_SB2 + U_SB1 + U_SB0 + n_ * 2 + (lo_ - 78) : U_SB2 + U_SB1 + U_SB0 + U_SA + n_ * 4 + (lo_ - 80)))); }
        if (u < U_SB2 + U_SB1 + U_SB0) {
            int n, hd, i0, nq, istep;
            if (u < U_SB2) { pi = 2; rr = 16; n = u / 48; hd = u % 6; c = (u - n * 48) / 6;     nq = 1; i0 = c; istep = 0; qf = 128; kf0 = 0; fmax = (2055 - c) >> 4; }
            else if (u < U_SB2 + U_SB1) { u -= U_SB2; pi = 1; rr = 4; n = u / 24; hd = u % 6; c = (u - n * 24) / 6; nq = 2; i0 = c; istep = 4; qf = 512 + r; kf0 = 384; fmax = (2055 - c) >> 2; }
            else { u -= U_SB2 + U_SB1; pi = 0; rr = 1; c = 0; hd = u % 6; n = u / 6; nq = 8; i0 = 0; istep = 1; qf = 2048 + r; kf0 = 1920; fmax = 2055; }
            qvalid = r < nq; const int rq = qvalid ? r : 0;
            if (!qvalid) qf = (pi == 2) ? 128 : (pi == 1 ? 512 : 2048);
            qrow = NP + n * 8 + i0 + istep * rq; head = hd; qcol = 384 + hd * 64; mode = 2;
            pitch = 384; L = 2048;
            kb0 = p.in[4] + (size_t)n * 2048 * 384 + hd * 64; vb0 = p.in[5] + (size_t)n * 2048 * 384 + hd * 64;
            kb1 = p.out + O_SDK + (size_t)n * 2048 * 384 + hd * 64; vb1 = p.out + O_SDV + (size_t)n * 2048 * 384 + hd * 64;
            cpy = pi == 2 ? 1 : (pi == 1 ? 2 : 0);
        } else if (u < U_SB2 + U_SB1 + U_SB0 + U_SA) {
            u -= U_SB2 + U_SB1 + U_SB0;
            const int kvh = u & 1, n = u >> 1;
            qvalid = r < 24; const int rq = qvalid ? r : 0;
            head = kvh * 3 + (rq >> 3); qrow = NP + n * 8 + (rq & 7); qcol = head * 64; qf = 128 + (rq & 7); mode = 1;
            pitch = 128; L = 128; kf0 = 0; fmax = 135;
            kb0 = p.in[2] + (size_t)n * 128 * 128 + kvh * 64; vb0 = p.in[3] + (size_t)n * 128 * 128 + kvh * 64;
            kb1 = p.out + O_SSK + (size_t)n * 128 * 128 + kvh * 64; vb1 = p.out + O_SSV + (size_t)n * 128 * 128 + kvh * 64;
        } else {
            u -= U_SB2 + U_SB1 + U_SB0 + U_SA;
            const int hd = u & 3, n = u >> 2;
            qvalid = r < 8; const int rq = qvalid ? r : 0;
            head = hd; qrow = NP + n * 8 + rq; qcol = 768 + hd * 64; qf = 1 << 20; W = 1 << 30; mode = 0;
            pitch = 256; L = 1 << 20; kf0 = 0; fmax = 255; nch = 8;
            kb0 = p.in[6] + (size_t)n * 256 * 256 + hd * 64; vb0 = p.in[7] + (size_t)n * 256 * 256 + hd * 64; kb1 = kb0; vb1 = vb0;
        }
        attn_core<true>(ZQ, qrow, qcol, qf, W, kb0, kb1, vb0, vb1, pitch, L, c, rr, fmax, kf0, nch, cpy, vlds, lane, m, l, O0, O1);
    } else {
        int u = uid - U_S_END;
        if (u < U_PB) {
            const int idx = u & 127; int t = u >> 7; pi = t % 3; t /= 3; const int hd = t % 6, b = t / 6;
            rr = pi == 0 ? 1 : (pi == 1 ? 4 : 16);
            const int tiles = 128 / rr; c = idx / tiles; const int ft = idx % tiles;
            qf = 32 * ft + r; qrow = b * 4096 + c + rr * qf; head = hd; qcol = 384 + hd * 64; mode = 2;
            pitch = 384; kf0 = 32 * ft - 128; fmax = 4096 / rr - 1;
            kb0 = (const bf16_t*)(ws + WS_KB) + (size_t)b * 4096 * 384 + hd * 64; vb0 = (const bf16_t*)(ws + WS_VB) + (size_t)b * 4096 * 384 + hd * 64;
        } else if (u < U_PB + U_PA) {
            u -= U_PB;
            const int tile = u & 127; const int t = u >> 7; const int hd = t % 6, b = t / 6, kvh = hd / 3;
            qf = 32 * tile + r; qrow = b * 4096 + qf; head = hd; qcol = hd * 64; mode = 1;
            pitch = 128; kf0 = 32 * tile - 128; fmax = 4095;
            kb0 = (const bf16_t*)(ws + WS_KA) + (size_t)b * 4096 * 128 + kvh * 64; vb0 = (const bf16_t*)(ws + WS_VA) + (size_t)b * 4096 * 128 + kvh * 64;
        } else {
            u -= U_PB + U_PA;
            const int tile = u & 127; const int t = u >> 7; const int hd = t & 3, b = t >> 2;
            qrow = b * 4096 + 32 * tile + r; head = hd; qcol = 768 + hd * 64; qf = 1 << 20; W = 1 << 30; mode = 0;
            pitch = 256; kf0 = 0; fmax = 255; nch = 8;
            kb0 = (const bf16_t*)(ws + WS_MK) + (size_t)b * 256 * 256 + hd * 64; vb0 = (const bf16_t*)(ws + WS_MV) + (size_t)b * 256 * 256 + hd * 64;
        }
        attn_core<false>(ZQ, qrow, qcol, qf, W, kb0, kb0, vb0, vb0, pitch, 1 << 30, c, rr, fmax, kf0, nch, 0, vlds, lane, m, l, O0, O1);
    }
    float scale;
    if (mode == 1) { const float s2 = p.in[11][head] * LOG2E; const float mm = fmaxf(m, s2); const float a = ex2(m - mm); scale = a / (l * a + ex2(s2 - mm)); }
    else scale = 1.f / l;
    if (qvalid) {
        bf16_t* dst = (mode == 2) ? BPO + ((size_t)pi * NT + qrow) * 384 + head * 64 : CAT + (size_t)qrow * 1024 + qcol;
#pragma unroll
        for (int i4 = 0; i4 < 4; ++i4) {
            f32x4 a = {O0[4 * i4] * scale, O0[4 * i4 + 1] * scale, O0[4 * i4 + 2] * scale, O0[4 * i4 + 3] * scale};
            f32x4 b = {O1[4 * i4] * scale, O1[4 * i4 + 1] * scale, O1[4 * i4 + 2] * scale, O1[4 * i4 + 3] * scale};
            *(u32x2*)(dst + 8 * i4 + 4 * h) = pack4(a);
            *(u32x2*)(dst + 32 + 8 * i4 + 4 * h) = pack4(b);
        }
        if (mode == 2 && h == 0) { f32x2_t ml = {m, l}; BPM[((size_t)pi * NT + qrow) * 6 + head] = ml; }
    }
}

__global__ void __launch_bounds__(512, 2) fwd_kernel(Params p) {
    extern __shared__ __attribute__((aligned(16))) unsigned char lds_raw[];
    LAS unsigned char* lds = (LAS unsigned char*)lds_raw;
    cg::grid_group grid = cg::this_grid();
    const int tid = threadIdx.x, lane = tid & 63, wave = __builtin_amdgcn_readfirstlane(tid >> 6);
    const int G = gridDim.x, gw = blockIdx.x * 8 + wave, NGW = G * 8, gt = blockIdx.x * 512 + tid, NGT = G * 512;
    unsigned char* ws = p.ws;
    bf16_t* WIN = (bf16_t*)(ws + WS_WIN); bf16_t* WO = (bf16_t*)(ws + WS_WO); bf16_t* WGU = (bf16_t*)(ws + WS_WGU); bf16_t* WD = (bf16_t*)(ws + WS_WD);
    bf16_t* AALL = (bf16_t*)(ws + WS_AALL); bf16_t* CAT = (bf16_t*)(ws + WS_CAT); bf16_t* TB = (bf16_t*)(ws + WS_T); bf16_t* ACT = (bf16_t*)(ws + WS_ACT);
    float* SS = (float*)(ws + WS_SS); float* PART = (float*)(ws + WS_PART); f32x2_t* ROT = (f32x2_t*)(ws + WS_ROT);
    float* Y = p.out + O_Y; bf16_t* X1B = (bf16_t*)(ws + WS_BPO);
    if (tid < 64) ((LAS unsigned*)(lds + 131072))[tid] = 0u;
    __syncthreads();
    const XcdBarrier xbar = xcd_barrier_post((unsigned*)(ws + WS_CTL) + 1024, (volatile LAS unsigned*)(lds + 131072));

    {
        LAS float* scr = (LAS float*)(lds + wave * 16384);
        constexpr int I_IN = 16 * 64, I_MEM = 16 * 16;
        for (int it = gw; it < I_IN + I_MEM; it += NGW) {
            if (it < I_IN) tr_item<1>(p.in[10], nullptr, 1024, 2048, 2048, WIN, 0, scr, it, lane);
            else tr_item<1>(p.in[12], nullptr, 1024, 512, 512, WIN, 2048, scr, it - I_IN, lane);
        }
        for (int row = NP + gw; row < NT + 1024; row += NGW) norm_row(p.in[0], p.in[1], p.in[8], p.in[9], AALL, row, lane);
        for (int idx = gt; idx < 4104 * 32; idx += NGT) {
            const int pp = idx >> 5, i = idx & 31; const int pos = pp < 4096 ? pp : 16384 + (pp - 4096);
            double rev = (double)pos * INVF[i] * 0.15915494309189535; rev -= __builtin_rint(rev);
            const float fr = (float)rev;
            f32x2_t cs = {__builtin_amdgcn_cosf(fr), __builtin_amdgcn_sinf(fr)};
            ROT[idx] = cs;
        }
    }
    if (p.ws == nullptr) grid.sync();
    xcd_barrier(xbar);

    constexpr int NXB = 40;
    if ((int)blockIdx.x < NXB) {
        Gemm g{AALL, WIN, NT + 1024, 2560, 1024};
        SchedX S; S.c = (int)blockIdx.x;
        EpiQKV E{ws, p.out, (const f32x4*)ROT};
        gemm_phase<EpiQKV, SchedX, true, true>(lds, g, S, E);
    } else {
        LAS float* scr = (LAS float*)(lds + wave * 16384);
        const int gw2 = ((int)blockIdx.x - NXB) * 8 + wave, NGW2 = (G - NXB) * 8, gt2 = ((int)blockIdx.x - NXB) * 512 + tid, NGT2 = (G - NXB) * 512;
        constexpr int I_O = 16 * 32, I_GU = 16 * 176, I_D = 44 * 32;
        for (int it = gw2; it < I_O + I_GU + I_D; it += NGW2) {
            int r = it;
            if (r < I_O) { tr_item<0>(p.in[13], nullptr, 1024, 1024, 1024, WO, 0, scr, r, lane); continue; } r -= I_O;
            if (r < I_GU) { tr_item<2>(p.in[16], p.in[17], 1024, 5632, 2816, WGU, 0, scr, r, lane); continue; } r -= I_GU;
            tr_item<0>(p.in[18], nullptr, 2816, 1024, 1024, WD, 0, scr, r, lane);
        }
        for (int row = gw2; row < NP; row += 2 * NGW2) {
            const int row1 = row + NGW2; const bool has1 = row1 < NP;
            const f32x4* x0 = (const f32x4*)(p.in[0] + (size_t)row * 1024) + lane; const f32x4* x1p = (const f32x4*)(p.in[0] + (size_t)(has1 ? row1 : row) * 1024) + lane;
            f32x4 a[4], b[4], g[4]; float sa = 0.f, sb = 0.f;
#pragma unroll
            for (int j = 0; j < 4; ++j) { a[j] = x0[64 * j]; b[j] = x1p[64 * j]; g[j] = ((const f32x4*)p.in[9])[lane + 64 * j]; }
#pragma unroll
            for (int j = 0; j < 4; ++j) { sa += (a[j][0] * a[j][0] + a[j][1] * a[j][1]) + (a[j][2] * a[j][2] + a[j][3] * a[j][3]); sb += (b[j][0] * b[j][0] + b[j][1] * b[j][1]) + (b[j][2] * b[j][2] + b[j][3] * b[j][3]); }
            sa = wave_sum(sa); sb = wave_sum(sb);
            const float ra = 1.0f / sqrtf(sa * (1.f / 1024.f) + EPS), rb = 1.0f / sqrtf(sb * (1.f / 1024.f) + EPS);
#pragma unroll
            for (int j = 0; j < 4; ++j) *(u32x2*)(AALL + (size_t)row * 1024 + 4 * lane + 256 * j) = pack4(a[j] * ra * g[j]);
            if (has1) {
#pragma unroll
                for (int j = 0; j < 4; ++j) *(u32x2*)(AALL + (size_t)row1 * 1024 + 4 * lane + 256 * j) = pack4(b[j] * rb * g[j]);
            }
        }
        copy_shift(p.in[2], p.out + O_SSK, 120 * 128 / 4, 8 * 128, 128 * 128, gt2, NGT2);
        copy_shift(p.in[3], p.out + O_SSV, 120 * 128 / 4, 8 * 128, 128 * 128, gt2, NGT2);
    }
    xcd_barrier(xbar);

    {
        Gemm g{AALL, WIN, NT + 1024, 2560, 1024};
        StaticOrder S; S.init(NP, 2048, G, (int)blockIdx.x);
        EpiQKV E{ws, p.out, (const f32x4*)ROT};
        gemm_phase<EpiQKV, StaticOrder, true, true>(lds, g, S, E);
    }
    xcd_barrier(xbar);

    {
        LAS unsigned char* vlds = lds + wave * 9216;
        constexpr int NCU = 2 * 128 * 24;
        constexpr int NM = U_S_END + NCU, NC = U_TOTAL - U_S_END;
        for (int k = 0; k * NGW < (NM > NC ? NM : NC); ++k) {
            const int ui = gw + k * NGW;
            for (int half = 0; half < 2; ++half) {
                const bool doM = ((half ^ wave) & 1) == 0;
                int uid = -1, cu = -1;
                if (doM) {
                    if (ui < U_S_END) {
                        uid = ui;
                        if (G == 256) {
                            const int x_ = (int)blockIdx.x & 7, ux_ = ((int)blockIdx.x >> 3) * 8 + wave + 256 * k;
                            uid = ux_ < 1344 ? ((ux_ / 84) * 8 + x_) * 84 + ux_ % 84 : -1;
                        }
                    } else if (ui < NM) cu = ui - U_S_END;
                } else if (ui < NC) {
                    uid = U_S_END + ui;
                    if (G == 256) {
                        const int x_ = (int)blockIdx.x & 7, ux_ = ((int)blockIdx.x >> 3) * 8 + wave + 256 * k;
                        const int j_ = ux_ >> 7;
                        const int grp_ = j_ < 9 ? (x_ * 3 + j_ / 3) * 3 + j_ % 3 : (j_ < 12 ? 72 + (x_ >> 1) * 6 + (x_ & 1) * 3 + (j_ - 9) : 96 + x_ * 2 + (j_ - 12));
                        uid = U_S_END + grp_ * 128 + (ux_ & 127);
                    }
                }
                if (uid >= 0) attn_unit(p, uid, lane, vlds);
                else if (cu >= 0) {
                    const int tensor = cu & 1, n = (cu >> 1) & 127, g4 = cu >> 8;
                    const float* src = p.in[4 + tensor] + (size_t)n * 2048 * 384; float* dst = p.out + (tensor ? O_SDV : O_SDK) + (size_t)n * 2048 * 384;
                    for (int jh = 0; jh < 4; jh += 2) {
                        f32x4 t[2][12];
#pragma unroll
                        for (int j = 0; j < 2; ++j) { const f32x4* sp = (const f32x4*)(src + (size_t)(16 * (4 * g4 + jh + j) + 8) * 384) + lane;
#pragma unroll
                            for (int i = 0; i < 12; ++i) t[j][i] = __builtin_nontemporal_load(sp + 64 * i); }
#pragma unroll
                        for (int j = 0; j < 2; ++j) { f32x4* dp = (f32x4*)(dst + (size_t)(16 * (4 * g4 + jh + j)) * 384) + lane;
#pragma unroll
                            for (int i = 0; i < 12; ++i) __builtin_nontemporal_store(t[j][i], dp + 64 * i); }
                    }
                }
            }
        }
    }
    xcd_barrier(xbar);

    {
        const bf16_t* BPO = (const bf16_t*)(ws + WS_BPO); const f32x2_t* BPM = (const f32x2_t*)(ws + WS_BPM);
        for (int idx = gt; idx < NT * 48; idx += NGT) {
            const int ch = idx & 7, t = idx >> 3, head = t % 6, row = t / 6;
            f32x2_t ml[3];
#pragma unroll
            for (int i = 0; i < 3; ++i) ml[i] = BPM[((size_t)i * NT + row) * 6 + head];
            const float M = fmaxf(ml[0][0], fmaxf(ml[1][0], ml[2][0]));
            float w[3], den = 0.f;
#pragma unroll
            for (int i = 0; i < 3; ++i) { w[i] = ml[i][1] * ex2(ml[i][0] - M); den += w[i]; }
            const float inv = 1.f / den;
            f32x4 a = {0.f, 0.f, 0.f, 0.f}, b = {0.f, 0.f, 0.f, 0.f};
#pragma unroll
            for (int i = 0; i < 3; ++i) {
                const u32x4 v = *(const u32x4*)(BPO + ((size_t)i * NT + row) * 384 + head * 64 + 8 * ch);
                u32x2 lo = {v.x, v.y}, hi = {v.z, v.w};
                a += unpack4(lo) * (w[i] * inv); b += unpack4(hi) * (w[i] * inv);
            }
            *(bf16x8*)(CAT + (size_t)row * 1024 + 384 + head * 64 + 8 * ch) = pack8(a, b);
        }
    }
    xcd_barrier(xbar);

    {
        Gemm g{CAT, WO, NT, 1024, 1024};
        SchedSK S; S.init(G, (int)blockIdx.x, 1024);
        EpiT E{TB, SS, PART};
        gemm_phase<EpiT, SchedSK, true, true>(lds, g, S, E);
    }
    xcd_barrier(xbar);

    int p4_first = gw;
    if (NGW == 2048) {
        const int lane = fresh_lane();
        f32x4 g1[4], g2[4];
#pragma unroll
        for (int j = 0; j < 4; ++j) { g1[j] = ((const f32x4*)p.in[14])[lane + 64 * j]; g2[j] = ((const f32x4*)p.in[15])[lane + 64 * j]; }
        for (int k0 = 0; k0 < 8; k0 += 2) {
            u32x2 tb[2][4]; f32x4 xv[2][4]; float ssq[2];
#pragma unroll
            for (int i = 0; i < 2; ++i) {
                const int row = gw + (k0 + i) * 2048;
#pragma unroll
                for (int j = 0; j < 4; ++j) { tb[i][j] = *(const u32x2*)(TB + (size_t)row * 1024 + 4 * lane + 256 * j); xv[i][j] = ((const f32x4*)(p.in[0] + (size_t)row * 1024))[lane + 64 * j]; }
                float a_ = 0.f;
#pragma unroll
                for (int s_ = 0; s_ < 16; ++s_) a_ += SS[(size_t)s_ * NT + row];
                ssq[i] = a_;
            }
            float s2[2];
#pragma unroll
            for (int i = 0; i < 2; ++i) {
                const int row = gw + (k0 + i) * 2048;
                const float rstd = 1.0f / sqrtf(ssq[i] * (1.f / 1024.f) + EPS);
                float q_ = 0.f;
#pragma unroll
                for (int j = 0; j < 4; ++j) {
                    xv[i][j] = xv[i][j] + unpack4(tb[i][j]) * rstd * g1[j];
                    *(u32x2*)(X1B + (size_t)row * 1024 + 4 * lane + 256 * j) = pack4(xv[i][j]);
                    q_ += (xv[i][j][0] * xv[i][j][0] + xv[i][j][1] * xv[i][j][1]) + (xv[i][j][2] * xv[i][j][2] + xv[i][j][3] * xv[i][j][3]);
                }
                s2[i] = q_;
            }
            s2[0] = wave_sum(s2[0]); s2[1] = wave_sum(s2[1]);
#pragma unroll
            for (int i = 0; i < 2; ++i) {
                const int row = gw + (k0 + i) * 2048;
                const float r2 = 1.0f / sqrtf(s2[i] * (1.f / 1024.f) + EPS);
#pragma unroll
                for (int j = 0; j < 4; ++j) *(u32x2*)(AALL + (size_t)row * 1024 + 4 * lane + 256 * j) = pack4(xv[i][j] * r2 * g2[j]);
            }
        }
        p4_first = gw + 8 * 2048;
    }
    for (int row = p4_first; row < NT; row += NGW) {
        const int lane = fresh_lane();
        float ss = 0.f; f32x4 tv[4];
        if (row < NP) {
#pragma unroll
            for (int s = 0; s < 16; ++s) ss += SS[(size_t)s * NT + row];
#pragma unroll
            for (int j = 0; j < 4; ++j) tv[j] = unpack4(*(const u32x2*)(TB + (size_t)row * 1024 + 4 * lane + 256 * j));
        } else {
#pragma unroll
            for (int j = 0; j < 4; ++j) tv[j] = (f32x4){0.f, 0.f, 0.f, 0.f};
            for (int s = 0; s < 4; ++s)
#pragma unroll
                for (int j = 0; j < 4; ++j) tv[j] += ((const f32x4*)(PART + ((size_t)s * 1024 + (row - NP)) * 1024))[lane + 64 * j];
#pragma unroll
            for (int j = 0; j < 4; ++j) ss += (tv[j][0] * tv[j][0] + tv[j][1] * tv[j][1]) + (tv[j][2] * tv[j][2] + tv[j][3] * tv[j][3]);
            ss = wave_sum(ss);
        }
        const float rstd = 1.0f / sqrtf(ss * (1.f / 1024.f) + EPS);
        const float* xr = row < NP ? p.in[0] + (size_t)row * 1024 : p.in[1] + (size_t)(row - NP) * 1024;
        f32x4 x1[4]; float s2 = 0.f;
#pragma unroll
        for (int j = 0; j < 4; ++j) {
            const f32x4 t = tv[j];
            const f32x4 g = ((const f32x4*)p.in[14])[lane + 64 * j];
            x1[j] = ((const f32x4*)xr)[lane + 64 * j] + t * rstd * g;
            *(u32x2*)(X1B + (size_t)row * 1024 + 4 * lane + 256 * j) = pack4(x1[j]);
            s2 += (x1[j][0] * x1[j][0] + x1[j][1] * x1[j][1]) + (x1[j][2] * x1[j][2] + x1[j][3] * x1[j][3]);
        }
        s2 = wave_sum(s2); const float r2 = 1.0f / sqrtf(s2 * (1.f / 1024.f) + EPS);
#pragma unroll
        for (int j = 0; j < 4; ++j) { const f32x4 g = ((const f32x4*)p.in[15])[lane + 64 * j]; *(u32x2*)(AALL + (size_t)row * 1024 + 4 * lane + 256 * j) = pack4(x1[j] * r2 * g); }
    }
    xcd_barrier(xbar);

    {
        Gemm g{AALL, WGU, NT, 5632, 1024};
        StaticOrder S; S.init(NT, 5632, G, (int)blockIdx.x);
        EpiAct E{ACT};
        gemm_phase<EpiAct, StaticOrder, true, true>(lds, g, S, E);
    }
    xcd_barrier(xbar);

    {
        Gemm g{ACT, WD, NT, 1024, DFF};
        SchedSK S; S.init(G, (int)blockIdx.x, DFF);
        EpiT E{TB, SS, PART};
        gemm_phase<EpiT, SchedSK, true, true>(lds, g, S, E);
    }
    xcd_barrier(xbar);

    int p7_first = gw;
    if (NGW == 2048) {
        const int lane = fresh_lane();
        f32x4 gq[4];
#pragma unroll
        for (int j = 0; j < 4; ++j) gq[j] = ((const f32x4*)p.in[19])[lane + 64 * j];
        for (int k0 = 0; k0 < 8; k0 += 4) {
            u32x2 tb[4][4], xb[4][4]; float ssq[4];
#pragma unroll
            for (int i = 0; i < 4; ++i) {
                const int row = gw + (k0 + i) * 2048;
#pragma unroll
                for (int j = 0; j < 4; ++j) { tb[i][j] = *(const u32x2*)(TB + (size_t)row * 1024 + 4 * lane + 256 * j); xb[i][j] = *(const u32x2*)(X1B + (size_t)row * 1024 + 4 * lane + 256 * j); }
                float a_ = 0.f;
#pragma unroll
                for (int s_ = 0; s_ < 16; ++s_) a_ += SS[(size_t)s_ * NT + row];
                ssq[i] = a_;
            }
#pragma unroll
            for (int i = 0; i < 4; ++i) {
                const int row = gw + (k0 + i) * 2048;
                const float rstd = 1.0f / sqrtf(ssq[i] * (1.f / 1024.f) + EPS);
#pragma unroll
                for (int j = 0; j < 4; ++j) ((f32x4*)(Y + (size_t)row * 1024))[lane + 64 * j] = unpack4(xb[i][j]) + unpack4(tb[i][j]) * rstd * gq[j];
            }
        }
        p7_first = gw + 8 * 2048;
    }
    for (int row = p7_first; row < NT; row += NGW) {
        const int lane = fresh_lane();
        float ss = 0.f; f32x4 tv[4];
        if (row < NP) {
#pragma unroll
            for (int s = 0; s < 16; ++s) ss += SS[(size_t)s * NT + row];
#pragma unroll
            for (int j = 0; j < 4; ++j) tv[j] = unpack4(*(const u32x2*)(TB + (size_t)row * 1024 + 4 * lane + 256 * j));
        } else {
#pragma unroll
            for (int j = 0; j < 4; ++j) tv[j] = (f32x4){0.f, 0.f, 0.f, 0.f};
            for (int s = 0; s < 11; ++s)
#pragma unroll
                for (int j = 0; j < 4; ++j) tv[j] += ((const f32x4*)(PART + ((size_t)s * 1024 + (row - NP)) * 1024))[lane + 64 * j];
#pragma unroll
            for (int j = 0; j < 4; ++j) ss += (tv[j][0] * tv[j][0] + tv[j][1] * tv[j][1]) + (tv[j][2] * tv[j][2] + tv[j][3] * tv[j][3]);
            ss = wave_sum(ss);
        }
        const float rstd = 1.0f / sqrtf(ss * (1.f / 1024.f) + EPS);
#pragma unroll
        for (int j = 0; j < 4; ++j) {
            const f32x4 t = tv[j];
            const f32x4 g = ((const f32x4*)p.in[19])[lane + 64 * j];
            const f32x4 x1v = unpack4(*(const u32x2*)(X1B + (size_t)row * 1024 + 4 * lane + 256 * j));
            ((f32x4*)(Y + (size_t)row * 1024))[lane + 64 * j] = x1v + t * rstd * g;
        }
    }
}

extern "C" void kernel_launch(void* const* d_in, const int* in_sizes, int n_in, void* d_out, int out_size, void* d_ws, size_t ws_size, hipStream_t stream) {
    static int grid_blocks = 0;
    if (!grid_blocks) {
        int dev = 0, cus = 0, per_cu = 0;
        (void)hipGetDevice(&dev);
        (void)hipDeviceGetAttribute(&cus, hipDeviceAttributeMultiprocessorCount, dev);
        if (hipFuncSetAttribute((const void*)fwd_kernel, hipFuncAttributeMaxDynamicSharedMemorySize, LDS_BYTES) != hipSuccess) fprintf(stderr, "hipFuncSetAttribute failed\n");
        if (hipOccupancyMaxActiveBlocksPerMultiprocessor(&per_cu, (const void*)fwd_kernel, 512, LDS_BYTES) != hipSuccess || per_cu < 1) { fprintf(stderr, "occupancy query: %d\n", per_cu); per_cu = 1; }
        (void)hipGetLastError();
        grid_blocks = cus;
        if (n_in != 20 || ws_size < WS_END) fprintf(stderr, "kernel_launch: unexpected n_in %d / ws_size %zu\n", n_in, ws_size);
    }
    (void)hipMemsetAsync((char*)d_ws + WS_CTL, 0, CTL_ZERO_BYTES, stream);
    Params p{};
    for (int i = 0; i < 20; ++i) p.in[i] = (const float*)d_in[i];
    p.out = (float*)d_out; p.ws = (unsigned char*)d_ws;
    void* args[] = {&p};
    hipError_t e = hipLaunchCooperativeKernel((const void*)fwd_kernel, dim3(grid_blocks), dim3(512), args, LDS_BYTES, stream);
    if (e != hipSuccess) fprintf(stderr, "cooperative launch failed: %s (grid %d)\n", hipGetErrorString(e), grid_blocks);
}
```
